# Optimizing an MI355X kernel written in HIP

```python
import math
import jax, jax.numpy as jnp
from jax import lax
import numpy as np

D_MODEL = 1024
BATCH = 16
SEQ = 2048
DEPTH = 2

NSA_HEADS = 8
NSA_KV_HEADS = 2
NSA_GROUP = NSA_HEADS // NSA_KV_HEADS
NSA_HEAD_DIM = 64
NSA_BRANCHES = 3
CMP_BLOCK = 32
CMP_STRIDE = 16
CMP_HIDDEN = 128
SEL_BLOCK = 64
SEL_TOPN = 8
WINDOW = 512
NSA_Q_BLOCK = 64
FORCE_BONUS = 1000.0
GLA_HEADS = 4
GLA_DK = 64
GLA_DV = 128
GLA_GATE_RANK = 16
GLA_TAU = 16.0
GLA_CHUNK = 64
MLA_HEADS = 16
MLA_NOPE = 64
MLA_ROPE = 32
MLA_V = 64
MLA_Q_LORA = 384
MLA_KV_LORA = 256
ROPE_THETA = 10000.0
ATTN_Q_BLOCK = 128
NORM_EPS = 1e-5
NEG_INF = -1e30
DEEPNORM_ALPHA = (2 * DEPTH) ** 0.25
DEEPNORM_BETA = (8 * DEPTH) ** -0.25
N_EVEN = (DEPTH + 1) // 2
N_ODD = DEPTH // 2

NSA_Q_W = NSA_HEADS * NSA_HEAD_DIM
NSA_KV_W = NSA_BRANCHES * 2 * NSA_KV_HEADS * NSA_HEAD_DIM
NSA_GATE_W = NSA_BRANCHES * NSA_HEADS
GLA_QK_W = GLA_HEADS * GLA_DK
GLA_V_W = GLA_HEADS * GLA_DV
EVEN_SPLITS = (NSA_Q_W, NSA_KV_W, NSA_GATE_W, NSA_Q_W, GLA_QK_W, GLA_QK_W, GLA_V_W, GLA_GATE_RANK, GLA_V_W)
EVEN_IN_W = 3368
EVEN_OUT_W = NSA_Q_W + GLA_V_W
MLA_Z_W = MLA_HEADS * MLA_V
ODD_SPLITS = (MLA_Q_LORA, MLA_KV_LORA, MLA_ROPE, MLA_Z_W)
ODD_IN_W = 1696

kernel_name = "nsa_gla_mla_deepnorm_hybrid"


def _split(h, sizes):
    out, off = [], 0
    for s in sizes:
        out.append(h[..., off:off + s])
        off += s
    return out


def _layernorm(x, g, b):
    xf = x.astype(jnp.float32)
    mu = jnp.mean(xf, -1, keepdims=True)
    var = jnp.mean(jnp.square(xf - mu), -1, keepdims=True)
    return ((xf - mu) * lax.rsqrt(var + NORM_EPS) * g + b).astype(x.dtype)


def _rmsnorm(x, g):
    xf = x.astype(jnp.float32)
    y = xf * lax.rsqrt(jnp.mean(jnp.square(xf), -1, keepdims=True) + NORM_EPS)
    return (y * g).astype(x.dtype)


def _alibi_slopes(n):
    return jnp.exp2(-(8.0 / n) * jnp.arange(1, n + 1, dtype=jnp.float32))


def _masked_softmax(s, mask):
    p = jax.nn.softmax(jnp.where(mask, s, NEG_INF), axis=-1)
    return p * mask


def _rope(x, pos):
    d = x.shape[-1]
    half = d // 2
    freqs = jnp.exp(-math.log(ROPE_THETA) * jnp.arange(half, dtype=jnp.float32) * 2.0 / d)
    ang = pos[:, None] * freqs[None, :]
    shape = (ang.shape[0],) + (1,) * (x.ndim - 3) + (half,)
    cos = jnp.cos(ang).reshape(shape).astype(x.dtype)
    sin = jnp.sin(ang).reshape(shape).astype(x.dtype)
    x1, x2 = x[..., :half], x[..., half:]
    return jnp.concatenate([x1 * cos - x2 * sin, x2 * cos + x1 * sin], -1)


def nsa_mixer(q, kv, gate_logits, cmp_pe, cmp_w1, cmp_w2):
    in_dtype = q.dtype
    B, S, _ = q.shape
    G, R, dh = NSA_KV_HEADS, NSA_GROUP, NSA_HEAD_DIM
    q = (q * dh ** -0.5).reshape(B, S, G, R, dh).transpose(0, 2, 3, 1, 4)
    kv = kv.reshape(B, S, NSA_BRANCHES, 2, G, dh).transpose(2, 3, 0, 4, 1, 5)
    slopes = _alibi_slopes(NSA_HEADS).reshape(G, R)[:, :, None, None]
    pos = jnp.arange(S)

    n_cmp = (S - CMP_BLOCK) // CMP_STRIDE + 1
    cmp_start = jnp.arange(n_cmp) * CMP_STRIDE
    cmp_idx = cmp_start[:, None] + jnp.arange(CMP_BLOCK)[None, :]

    def compress(t, j):
        blk = t[:, :, cmp_idx] + cmp_pe[j]
        h = jax.nn.silu(blk.reshape(B, G, n_cmp, CMP_BLOCK * dh) @ cmp_w1[j])
        return h @ cmp_w2[j]

    k_cmp = compress(kv[0, 0], 0)
    v_cmp = compress(kv[0, 1], 1)
    cmp_end = cmp_start + CMP_BLOCK - 1
    dist_c = (pos[:, None] - cmp_end[None, :]).astype(jnp.float32)
    s = jnp.einsum('bgrtd,bgnd->bgrtn', q, k_cmp).astype(jnp.float32) - slopes * dist_c
    p_cmp = _masked_softmax(s, dist_c >= 0)
    o_cmp = jnp.einsum('bgrtn,bgnd->bgrtd', p_cmp.astype(v_cmp.dtype), v_cmp)

    n_sel = S // SEL_BLOCK
    n_top = min(SEL_TOPN, n_sel)
    sel_start = jnp.arange(n_sel) * SEL_BLOCK
    overlap = jnp.clip(
        jnp.minimum(cmp_start[:, None] + CMP_BLOCK, sel_start[None, :] + SEL_BLOCK)
        - jnp.maximum(cmp_start[:, None], sel_start[None, :]), 0).astype(jnp.float32) / CMP_BLOCK
    imp = jnp.einsum('bgrtn,nj->bgtj', p_cmp, overlap)
    cur = (pos // SEL_BLOCK)[:, None]
    jj = jnp.arange(n_sel)[None, :]
    forced = (jj == 0) | (jj == cur) | (jj == cur - 1)
    imp = jnp.where(jj > cur, -1.0, imp + jnp.where(forced, FORCE_BONUS, 0.0))
    _, sel_idx = lax.top_k(imp, n_top)

    k_sel = kv[1, 0].reshape(B, G, n_sel, SEL_BLOCK, dh)
    v_sel = kv[1, 1].reshape(B, G, n_sel, SEL_BLOCK, dh)
    pad = ((0, 0), (0, 0), (WINDOW, 0), (0, 0))
    k_win = jnp.pad(kv[2, 0], pad)
    v_win = jnp.pad(kv[2, 1], pad)

    qb_len = NSA_Q_BLOCK
    n_qb = S // qb_len
    q_blocks = q.reshape(B, G, R, n_qb, qb_len, dh).transpose(3, 0, 1, 2, 4, 5)
    idx_blocks = sel_idx.reshape(B, G, n_qb, qb_len, n_top).transpose(2, 0, 1, 3, 4)
    starts = jnp.arange(n_qb) * qb_len
    bi = jnp.arange(B)[:, None, None, None]
    gi = jnp.arange(G)[None, :, None, None]
    n_keys = n_top * SEL_BLOCK

    def block(args):
        qb, ib, start = args
        tq = start + jnp.arange(qb_len)
        ks = k_sel[bi, gi, ib].reshape(B, G, qb_len, n_keys, dh)
        vs = v_sel[bi, gi, ib].reshape(B, G, qb_len, n_keys, dh)
        kpos = (ib[..., None] * SEL_BLOCK + jnp.arange(SEL_BLOCK)).reshape(B, G, qb_len, n_keys)
        d_s = (tq[:, None] - kpos).astype(jnp.float32)[:, :, None]
        s_s = jnp.einsum('bgrqd,bgqkd->bgrqk', qb, ks).astype(jnp.float32) - slopes * d_s
        p_s = _masked_softmax(s_s, d_s >= 0)
        o_s = jnp.einsum('bgrqk,bgqkd->bgrqd', p_s.astype(vs.dtype), vs)
        kw = lax.dynamic_slice_in_dim(k_win, start, qb_len + WINDOW, axis=2)
        vw = lax.dynamic_slice_in_dim(v_win, start, qb_len + WINDOW, axis=2)
        kp = start - WINDOW + jnp.arange(qb_len + WINDOW)
        d_w = tq[:, None] - kp[None, :]
        mask_w = (d_w >= 0) & (d_w < WINDOW) & (kp[None, :] >= 0)
        s_w = jnp.einsum('bgrqd,bgkd->bgrqk', qb, kw).astype(jnp.float32) - slopes * d_w.astype(jnp.float32)
        p_w = _masked_softmax(s_w, mask_w)
        o_w = jnp.einsum('bgrqk,bgkd->bgrqd', p_w.astype(vw.dtype), vw)
        return o_s, o_w

    o_sel, o_win = lax.map(block, (q_blocks, idx_blocks, starts))
    o_sel = o_sel.transpose(1, 2, 3, 0, 4, 5).reshape(B, G, R, S, dh)
    o_win = o_win.transpose(1, 2, 3, 0, 4, 5).reshape(B, G, R, S, dh)

    g = jax.nn.sigmoid(gate_logits.astype(jnp.float32)).reshape(B, S, NSA_BRANCHES, G, R)
    g = g.transpose(2, 0, 3, 4, 1)[..., None]
    o = g[0] * o_cmp + g[1] * o_sel + g[2] * o_win
    return o.transpose(0, 3, 1, 2, 4).reshape(B, S, NSA_Q_W).astype(in_dtype)


def gla_mixer(q, k, v, gate_low, w_gate, b_gate, norm_g):
    in_dtype = q.dtype
    B, S, _ = q.shape
    H, C = GLA_HEADS, GLA_CHUNK
    n = S // C

    def heads(t, d):
        return t.astype(jnp.float32).reshape(B, n, C, H, d).transpose(0, 3, 1, 2, 4)

    q = heads(q, GLA_DK) * GLA_DK ** -0.5
    k = heads(k, GLA_DK)
    v = heads(v, GLA_DV)
    log_a = jax.nn.log_sigmoid((gate_low @ w_gate + b_gate).astype(jnp.float32)) / GLA_TAU
    b = jnp.cumsum(heads(log_a, GLA_DK), axis=3)
    b_last = b[:, :, :, -1:]
    q_d = q * jnp.exp(b)
    k_d = k * jnp.exp(-b)
    causal = jnp.tril(jnp.ones((C, C), dtype=bool))
    a = jnp.where(causal, jnp.einsum('bhncd,bhnsd->bhncs', q_d, k_d), 0.0)
    o_intra = jnp.einsum('bhncs,bhnse->bhnce', a, v)
    upd = jnp.einsum('bhnsd,bhnse->nbhde', k * jnp.exp(b_last - b), v)
    decay = jnp.exp(b_last[:, :, :, 0]).transpose(2, 0, 1, 3)

    def step(state, inp):
        dec, u = inp
        return dec[..., None] * state + u, state

    _, states = lax.scan(step, jnp.zeros((B, H, GLA_DK, GLA_DV), jnp.float32), (decay, upd))
    o_inter = jnp.einsum('bhncd,nbhde->bhnce', q_d, states)
    o = _rmsnorm(o_intra + o_inter, norm_g)
    return o.transpose(0, 2, 3, 1, 4).reshape(B, S, GLA_V_W).astype(in_dtype)


def mla_mixer(c_q, c_kv, k_rope, q_norm, w_uq, kv_norm, w_ukv):
    B, S, _ = c_q.shape
    H = MLA_HEADS
    pos_f = jnp.arange(S, dtype=jnp.float32)
    q = (_rmsnorm(c_q, q_norm) @ w_uq).reshape(B, S, H, MLA_NOPE + MLA_ROPE)
    q_nope = q[..., :MLA_NOPE]
    q_rope = _rope(q[..., MLA_NOPE:], pos_f)
    kv = (_rmsnorm(c_kv, kv_norm) @ w_ukv).reshape(B, S, H, MLA_NOPE + MLA_V)
    k_nope, v = kv[..., :MLA_NOPE], kv[..., MLA_NOPE:]
    k_rope = _rope(k_rope, pos_f)
    scale = (MLA_NOPE + MLA_ROPE) ** -0.5
    n_qb = S // ATTN_Q_BLOCK
    qn_b = (q_nope * scale).reshape(B, n_qb, ATTN_Q_BLOCK, H, MLA_NOPE).transpose(1, 0, 2, 3, 4)
    qr_b = (q_rope * scale).reshape(B, n_qb, ATTN_Q_BLOCK, H, MLA_ROPE).transpose(1, 0, 2, 3, 4)
    starts = jnp.arange(n_qb) * ATTN_Q_BLOCK
    kpos = jnp.arange(S)

    def block(args):
        qn, qr, start = args
        tq = start + jnp.arange(ATTN_Q_BLOCK)
        s = (jnp.einsum('bqhd,bkhd->bhqk', qn, k_nope)
             + jnp.einsum('bqhd,bkd->bhqk', qr, k_rope)).astype(jnp.float32)
        p = _masked_softmax(s, kpos[None, :] <= tq[:, None])
        return jnp.einsum('bhqk,bkhd->bqhd', p.astype(v.dtype), v)

    o = lax.map(block, (qn_b, qr_b, starts))
    return o.transpose(1, 0, 2, 3, 4).reshape(B, S, MLA_Z_W)


def even_layer(x, w_in, cmp_pe, cmp_w1, cmp_w2, gla_w_gate, gla_b_gate, gla_norm, w_out, ln_g, ln_b):
    h = x @ w_in
    nq, nkv, ng, nz, gq, gk, gv, ga, gz = _split(h, EVEN_SPLITS)
    o_nsa = nsa_mixer(nq, nkv, ng, cmp_pe, cmp_w1, cmp_w2) * jax.nn.silu(nz)
    o_gla = gla_mixer(gq, gk, gv, ga, gla_w_gate, gla_b_gate, gla_norm) * jax.nn.silu(gz)
    y = jnp.concatenate([o_nsa, o_gla], axis=-1) @ w_out
    return _layernorm(DEEPNORM_ALPHA * x + y, ln_g, ln_b)


def odd_layer(x, w_in, q_norm, w_uq, kv_norm, w_ukv, w_out, ln_g, ln_b):
    h = x @ w_in
    cq, ckv, kr, z = _split(h, ODD_SPLITS)
    o = mla_mixer(cq, ckv, kr, q_norm, w_uq, kv_norm, w_ukv) * jax.nn.silu(z)
    y = o @ w_out
    return _layernorm(DEEPNORM_ALPHA * x + y, ln_g, ln_b)


def setup_inputs(seed: int = 0) -> dict:
    key = jax.random.key(seed)
    ks = jax.random.split(key, 19)

    def nrm(k, shape, scale):
        return jax.random.normal(k, shape, jnp.float32) * scale

    E, O = N_EVEN, N_ODD
    return {
        "x": nrm(ks[0], (BATCH, SEQ, D_MODEL), 1.0),
        "e_w_in": nrm(ks[1], (E, D_MODEL, EVEN_IN_W), D_MODEL ** -0.5),
        "e_cmp_pe": nrm(ks[2], (E, 2, CMP_BLOCK, NSA_HEAD_DIM), 0.02),
        "e_cmp_w1": nrm(ks[3], (E, 2, CMP_BLOCK * NSA_HEAD_DIM, CMP_HIDDEN), (CMP_BLOCK * NSA_HEAD_DIM) ** -0.5),
        "e_cmp_w2": nrm(ks[4], (E, 2, CMP_HIDDEN, NSA_HEAD_DIM), CMP_HIDDEN ** -0.5),
        "e_gla_w_gate": nrm(ks[5], (E, GLA_GATE_RANK, GLA_QK_W), GLA_GATE_RANK ** -0.5),
        "e_gla_b_gate": nrm(ks[6], (E, GLA_QK_W), 0.1),
        "e_gla_norm": 1.0 + nrm(ks[7], (E, GLA_DV), 0.02),
        "e_w_out": nrm(ks[8], (E, EVEN_OUT_W, D_MODEL), EVEN_OUT_W ** -0.5 * DEEPNORM_BETA),
        "e_ln_g": 1.0 + nrm(ks[9], (E, D_MODEL), 0.02),
        "e_ln_b": nrm(ks[10], (E, D_MODEL), 0.02),
        "o_w_in": nrm(ks[11], (O, D_MODEL, ODD_IN_W), D_MODEL ** -0.5),
        "o_q_norm": 1.0 + nrm(ks[12], (O, MLA_Q_LORA), 0.02),
        "o_w_uq": nrm(ks[13], (O, MLA_Q_LORA, MLA_HEADS * (MLA_NOPE + MLA_ROPE)), MLA_Q_LORA ** -0.5),
        "o_kv_norm": 1.0 + nrm(ks[14], (O, MLA_KV_LORA), 0.02),
        "o_w_ukv": nrm(ks[15], (O, MLA_KV_LORA, MLA_HEADS * (MLA_NOPE + MLA_V)), MLA_KV_LORA ** -0.5),
        "o_w_out": nrm(ks[16], (O, MLA_Z_W, D_MODEL), MLA_Z_W ** -0.5 * DEEPNORM_BETA),
        "o_ln_g": 1.0 + nrm(ks[17], (O, D_MODEL), 0.02),
        "o_ln_b": nrm(ks[18], (O, D_MODEL), 0.02),
    }


def reference(x, e_w_in, e_cmp_pe, e_cmp_w1, e_cmp_w2, e_gla_w_gate, e_gla_b_gate, e_gla_norm,
              e_w_out, e_ln_g, e_ln_b, o_w_in, o_q_norm, o_w_uq, o_kv_norm, o_w_ukv, o_w_out,
              o_ln_g, o_ln_b):
    for layer in range(DEPTH):
        i = layer // 2
        if layer % 2 == 0:
            x = even_layer(x, e_w_in[i], e_cmp_pe[i], e_cmp_w1[i], e_cmp_w2[i], e_gla_w_gate[i],
                           e_gla_b_gate[i], e_gla_norm[i], e_w_out[i], e_ln_g[i], e_ln_b[i])
        else:
            x = odd_layer(x, o_w_in[i], o_q_norm[i], o_w_uq[i], o_kv_norm[i], o_w_ukv[i],
                          o_w_out[i], o_ln_g[i], o_ln_b[i])
    return x
```

```cpp
#include <hip/hip_runtime.h>
#include <hip/hip_cooperative_groups.h>
#include <cstdio>
namespace cg = cooperative_groups;

#define DI __device__ __forceinline__
typedef unsigned short bf16_t;
typedef __attribute__((ext_vector_type(8))) short bf16x8;
typedef __attribute__((ext_vector_type(4))) short s16x4;
typedef __attribute__((ext_vector_type(16))) float f32x16;
typedef __attribute__((ext_vector_type(4))) unsigned u32x4;
#define MFMA32(a, b, c) __builtin_amdgcn_mfma_f32_32x32x16_bf16((a), (b), (c), 0, 0, 0)

constexpr int S = 2048, T = 16 * 2048;
constexpr int H0LD = 3392, H0N = 3456, H1LD = 1696, H1N = 1792;
constexpr int LDS_ROW = 144;
constexpr float LOG2E = 1.4426950408889634f;
constexpr float ALPHA = 1.4142135623730951f;
constexpr float EPS = 1e-5f;

constexpr size_t al256(size_t x) { return (x + 255) & ~size_t(255); }
constexpr size_t OFF_CTR = 0;
constexpr size_t OFF_WT_IN0 = 16384;
constexpr size_t OFF_WT_OUT0 = OFF_WT_IN0 + (size_t)H0N * 1024 * 2;
constexpr size_t OFF_WT_IN1 = OFF_WT_OUT0 + (size_t)1024 * 1024 * 2;
constexpr size_t OFF_WT_UQ = OFF_WT_IN1 + (size_t)H1N * 1024 * 2;
constexpr size_t OFF_WT_UKV = OFF_WT_UQ + (size_t)1536 * 384 * 2;
constexpr size_t OFF_WT_OUT1 = OFF_WT_UKV + (size_t)2048 * 256 * 2;
constexpr size_t OFF_W1T = OFF_WT_OUT1 + (size_t)1024 * 1024 * 2;
constexpr size_t OFF_W2T = OFF_W1T + (size_t)2 * 128 * 2048 * 2;
constexpr size_t OFF_BIAS1 = OFF_W2T + (size_t)2 * 64 * 128 * 2;
constexpr size_t OFF_REGB = al256(OFF_BIAS1 + 2 * 128 * 4);
constexpr size_t REGB_SZ = (size_t)T * H0LD * 2;
constexpr size_t OFF_H1 = OFF_REGB;
constexpr size_t OFF_Q1 = OFF_REGB + al256((size_t)T * H1LD * 2);
constexpr size_t OFF_REGC = OFF_REGB + REGB_SZ;
constexpr size_t OFF_VTNSA = OFF_REGC;
constexpr size_t OFF_VTGLA = OFF_VTNSA + (size_t)16 * 256 * 2048 * 2;
constexpr size_t OFF_KCMP = OFF_VTGLA + (size_t)16 * 512 * 2048 * 2;
constexpr size_t OFF_VCMPT = OFF_KCMP + (size_t)16 * 2 * 128 * 64 * 2;
constexpr size_t OFF_K1 = OFF_REGC;
constexpr size_t OFF_REGD = OFF_REGC + (size_t)T * 1024 * 2;
constexpr size_t OFF_REGF = OFF_REGD + (size_t)T * 1024 * 2;
constexpr size_t OFF_KR = OFF_REGF + (size_t)T * 1024 * 2;
constexpr size_t OFF_RINV = OFF_KR + (size_t)T * 32 * 2;
constexpr size_t OFF_QD = OFF_RINV + (size_t)T * 2 * 4;
constexpr size_t OFF_OI = OFF_QD + (size_t)T * 256 * 2;
constexpr size_t OFF_ST = OFF_OI + (size_t)T * 512 * 2;
constexpr size_t OFF_DEC = OFF_ST + (size_t)2048 * 128 * 64 * 2;
constexpr size_t OFF_UPD = OFF_REGF;
constexpr size_t OFF_SSQ = OFF_DEC + (size_t)2048 * 64 * 4;
constexpr size_t WS_TOTAL = OFF_SSQ + (size_t)T * 8 * 4;
static_assert(WS_TOTAL <= (size_t)536870912, "ws budget");
static_assert(OFF_Q1 + (size_t)T * 1536 * 2 <= OFF_REGC, "regB");
static_assert(OFF_VCMPT + (size_t)16 * 2 * 64 * 128 * 2 <= OFF_REGD, "regC");

constexpr int SMEM_BYTES = 73728 + 1024 + 64;

struct Params {
  const float *x, *e_w_in, *e_cmp_pe, *e_cmp_w1, *e_cmp_w2, *e_gla_w_gate, *e_gla_b_gate, *e_gla_norm, *e_w_out, *e_ln_g, *e_ln_b;
  const float *o_w_in, *o_q_norm, *o_w_uq, *o_kv_norm, *o_w_ukv, *o_w_out, *o_ln_g, *o_ln_b;
  float* out;
  char* ws;
  int phase_begin, phase_end;
};

typedef __bf16 bf2_t __attribute__((ext_vector_type(2)));
typedef float f2_t __attribute__((ext_vector_type(2)));
DI unsigned pack2(float a, float b) { f2_t v = {a, b}; bf2_t r = __builtin_convertvector(v, bf2_t); return __builtin_bit_cast(unsigned, r); }
DI unsigned f2bf(float x) { return pack2(x, 0.f) & 0xffffu; }
DI float bflo(unsigned u) { return __uint_as_float(u << 16); }
DI float bfhi(unsigned u) { return __uint_as_float(u & 0xffff0000u); }
DI float bf2f(bf16_t s) { return __uint_as_float(((unsigned)s) << 16); }
DI int crow(int i, int h) { return (i & 3) + 8 * (i >> 2) + 4 * h; }
DI uint2 pack4(float a, float b, float c, float d) { uint2 r; r.x = pack2(a, b); r.y = pack2(c, d); return r; }
DI float fexp2(float x) { return __builtin_amdgcn_exp2f(x); }
DI float silu(float v) { return v / (1.f + __expf(-v)); }
DI bf16x8 pack8(const f32x16& x, int s8) {
  union { uint4 u; bf16x8 v; } r;
  r.u.x = pack2(x[s8 + 0], x[s8 + 1]); r.u.y = pack2(x[s8 + 2], x[s8 + 3]);
  r.u.z = pack2(x[s8 + 4], x[s8 + 5]); r.u.w = pack2(x[s8 + 6], x[s8 + 7]);
  return r.v;
}
DI bf16x8 ld2x8(const char* p) {
  union { uint4 u; bf16x8 v; } r;
  uint2 a = *(const uint2*)p, b = *(const uint2*)(p + 16);
  r.u.x = a.x; r.u.y = a.y; r.u.z = b.x; r.u.w = b.y;
  return r.v;
}

struct SrcRM { const bf16_t* base; int ld; DI const bf16_t* ptr(int row, int k0, int kc) const { return base + (size_t)row * ld + k0 + kc * 8; } };
struct SrcCmp { const bf16_t* base; DI const bf16_t* ptr(int row, int k0, int kc) const { int n = row > 126 ? 126 : row; return base + (size_t)(16 * n + (k0 >> 6)) * H0LD + kc * 8; } };

template <int PT, int QT, class SP, class SQ>
DI void gemm_tile(char* smem, const SP& sp, int prow0, const SQ& sq, int qrow0, int K, f32x16 (&acc)[PT][QT]) {
  constexpr int PB = 64 * PT * LDS_ROW, STG = 64 * (PT + QT) * LDS_ROW;
  const int tid = threadIdx.x, lane = tid & 63, w = __builtin_amdgcn_readfirstlane(tid >> 6), wp = w >> 1, wq = w & 1, r = lane & 31, h = lane >> 5;
  u32x4 rpA[2 * PT], rqA[2 * QT];
#pragma unroll
  for (int ip = 0; ip < PT; ip++)
#pragma unroll
    for (int iq = 0; iq < QT; iq++)
#pragma unroll
      for (int i = 0; i < 16; i++) acc[ip][iq][i] = 0.f;
#define GT_GLOAD(RP, RQ, K0) { _Pragma("unroll") for (int i = 0; i < 2 * PT; i++) { int c = tid + 256 * i; RP[i] = *(const u32x4*)sp.ptr(prow0 + (c >> 3), (K0), c & 7); } \
    _Pragma("unroll") for (int i = 0; i < 2 * QT; i++) { int c = tid + 256 * i; RQ[i] = *(const u32x4*)sq.ptr(qrow0 + (c >> 3), (K0), c & 7); } }
#define GT_SSTORE(RP, RQ, ST) { char* st_ = (ST); _Pragma("unroll") for (int i = 0; i < 2 * PT; i++) { int c = tid + 256 * i; *(u32x4*)(st_ + (c >> 3) * LDS_ROW + (c & 7) * 16) = RP[i]; } \
    _Pragma("unroll") for (int i = 0; i < 2 * QT; i++) { int c = tid + 256 * i; *(u32x4*)(st_ + PB + (c >> 3) * LDS_ROW + (c & 7) * 16) = RQ[i]; } }
#define GT_COMPUTE(ST) { const char* sP = (ST); const char* sQ = sP + PB; __builtin_amdgcn_iglp_opt(0); \
    _Pragma("unroll") for (int s = 0; s < 4; s++) { bf16x8 a[PT], b[QT]; \
      _Pragma("unroll") for (int ip = 0; ip < PT; ip++) a[ip] = *(const bf16x8*)(sP + ((wp * PT + ip) * 32 + r) * LDS_ROW + s * 32 + h * 16); \
      _Pragma("unroll") for (int iq = 0; iq < QT; iq++) b[iq] = *(const bf16x8*)(sQ + ((wq * QT + iq) * 32 + r) * LDS_ROW + s * 32 + h * 16); \
      _Pragma("unroll") for (int ip = 0; ip < PT; ip++) _Pragma("unroll") for (int iq = 0; iq < QT; iq++) acc[ip][iq] = MFMA32(a[ip], b[iq], acc[ip][iq]); } }
  const int nk = K >> 6;
  GT_GLOAD(rpA, rqA, 0);
  GT_SSTORE(rpA, rqA, smem);
  if (nk > 1) GT_GLOAD(rpA, rqA, 64);
  for (int kt = 0; kt < nk; kt++) {
    __syncthreads();
    if (kt + 1 < nk) {
      GT_SSTORE(rpA, rqA, smem + ((kt + 1) & 1) * STG);
      if (kt + 2 < nk) GT_GLOAD(rpA, rqA, (kt + 2) * 64);
    }
    __builtin_amdgcn_sched_barrier(0);
    GT_COMPUTE(smem + (kt & 1) * STG);
  }
  __syncthreads();
#undef GT_GLOAD
#undef GT_SSTORE
#undef GT_COMPUTE
}

DI void epi_store_bf16(char* smem, const f32x16 (&acc)[2][2], bf16_t* dst, size_t ld, int valid) {
  const int tid = threadIdx.x, lane = tid & 63, w = __builtin_amdgcn_readfirstlane(tid >> 6), wp = w >> 1, wq = w & 1, r = lane & 31, h = lane >> 5;
#pragma unroll
  for (int ip = 0; ip < 2; ip++)
#pragma unroll
    for (int iq = 0; iq < 2; iq++)
#pragma unroll
      for (int gg = 0; gg < 4; gg++)
        *(uint2*)(smem + ((wq * 2 + iq) * 32 + r) * 272 + ((wp * 2 + ip) * 32 + 8 * gg + 4 * h) * 2) = pack4(acc[ip][iq][4 * gg], acc[ip][iq][4 * gg + 1], acc[ip][iq][4 * gg + 2], acc[ip][iq][4 * gg + 3]);
  __syncthreads();
#pragma unroll
  for (int i = 0; i < 8; i++) {
    int c = tid + 256 * i; int row = c >> 4, ch = c & 15;
    if (ch * 8 < valid) *(uint4*)(dst + (size_t)row * ld + ch * 8) = *(const uint4*)(smem + row * 272 + ch * 16);
  }
  __syncthreads();
}
DI void epi_store_bf16_ssq(char* smem, const f32x16 (&acc)[2][2], bf16_t* dst, size_t ld, int valid, float* ssq) {
  int tid_ = threadIdx.x; asm volatile("" : "+v"(tid_));
  const int tid = tid_, lane = tid & 63, w = __builtin_amdgcn_readfirstlane(tid >> 6), wp = w >> 1, wq = w & 1, r = lane & 31, h = lane >> 5;
#pragma unroll
  for (int ip = 0; ip < 2; ip++)
#pragma unroll
    for (int iq = 0; iq < 2; iq++)
#pragma unroll
      for (int gg = 0; gg < 4; gg++)
        *(uint2*)(smem + ((wq * 2 + iq) * 32 + r) * 272 + ((wp * 2 + ip) * 32 + 8 * gg + 4 * h) * 2) = pack4(acc[ip][iq][4 * gg], acc[ip][iq][4 * gg + 1], acc[ip][iq][4 * gg + 2], acc[ip][iq][4 * gg + 3]);
  __syncthreads();
#pragma unroll
  for (int i = 0; i < 8; i++) {
    int c = tid + 256 * i; int row = c >> 4, ch = c & 15;
    uint4 u = *(const uint4*)(smem + row * 272 + ch * 16);
    if (ch * 8 < valid) *(uint4*)(dst + (size_t)row * ld + ch * 8) = u;
    if (ssq) {
      float a0 = bflo(u.x), a1 = bfhi(u.x), a2 = bflo(u.y), a3 = bfhi(u.y), a4 = bflo(u.z), a5 = bfhi(u.z), a6 = bflo(u.w), a7 = bfhi(u.w);
      float s = a0 * a0 + a1 * a1 + a2 * a2 + a3 * a3 + a4 * a4 + a5 * a5 + a6 * a6 + a7 * a7;
      s += __shfl_xor(s, 8); s += __shfl_xor(s, 4); s += __shfl_xor(s, 2); s += __shfl_xor(s, 1);
      if (ch == 0) ssq[row] = s;
    }
  }
  __syncthreads();
}
DI void epi_store_f32_resid(char* smem, const f32x16 (&acc)[2][2], float* dst, const float* xres, size_t ld) {
  const int tid = threadIdx.x, lane = tid & 63, w = __builtin_amdgcn_readfirstlane(tid >> 6), wp = w >> 1, wq = w & 1, r = lane & 31, h = lane >> 5;
#pragma unroll
  for (int ip = 0; ip < 2; ip++)
#pragma unroll
    for (int iq = 0; iq < 2; iq++)
#pragma unroll
      for (int gg = 0; gg < 4; gg++) {
        float4 v; v.x = acc[ip][iq][4 * gg]; v.y = acc[ip][iq][4 * gg + 1]; v.z = acc[ip][iq][4 * gg + 2]; v.w = acc[ip][iq][4 * gg + 3];
        *(float4*)(smem + ((wq * 2 + iq) * 32 + r) * 528 + ((wp * 2 + ip) * 32 + 8 * gg + 4 * h) * 4) = v;
      }
  __syncthreads();
#pragma unroll
  for (int i = 0; i < 16; i++) {
    int c = tid + 256 * i; int row = c >> 5, ch = c & 31;
    float4 y = *(const float4*)(smem + row * 528 + ch * 16);
    float4 xv = *(const float4*)(xres + (size_t)row * ld + ch * 4);
    y.x += ALPHA * xv.x; y.y += ALPHA * xv.y; y.z += ALPHA * xv.z; y.w += ALPHA * xv.w;
    *(float4*)(dst + (size_t)row * ld + ch * 4) = y;
  }
  __syncthreads();
}

DI int map_h0(int n) {
  if (n < 1280) return n;
  if (n < 1792) return 1304 + (n - 1280);
  if (n < 2048) return 1816 + (n - 1792);
  if (n < 2304) return 2072 + (n - 2048);
  if (n < 2816) return 2328 + (n - 2304);
  if (n < 3328) return 2856 + (n - 2816);
  if (n < 3352) return 1280 + (n - 3328);
  if (n < 3360) return -1;
  if (n < 3376) return 2840 + (n - 3360);
  return -1;
}
DI int map_h1(int n) {
  if (n < 640) return n;
  if (n < 1664) return 672 + (n - 640);
  if (n < 1696) return 640 + (n - 1664);
  return -1;
}
DI int map_kv(int n) {
  if (n < 1024) return (n >> 6) * 128 + (n & 63);
  n -= 1024;
  return (n >> 6) * 128 + 64 + (n & 63);
}
DI void prep_tile(char* smem, bf16_t* dst, int K, const float* src, int ld, int mapid, const float* scale, int n0, int k0) {
  float* t = (float*)smem;
  const int tid = threadIdx.x;
  {
    int nl = tid & 63, kg = tid >> 6, n = n0 + nl;
    int sc = mapid == 0 ? n : mapid == 1 ? map_h0(n) : mapid == 2 ? map_h1(n) : map_kv(n);
#pragma unroll 4
    for (int i = 0; i < 16; i++) {
      int k = kg * 16 + i;
      float v = sc >= 0 ? src[(size_t)(k0 + k) * ld + sc] : 0.f;
      if (scale) v *= scale[k0 + k];
      t[k * 65 + nl] = v;
    }
  }
  __syncthreads();
  {
    int n = tid >> 2, kq = (tid & 3) * 16;
    uint4 a, b;
    a.x = pack2(t[(kq + 0) * 65 + n], t[(kq + 1) * 65 + n]); a.y = pack2(t[(kq + 2) * 65 + n], t[(kq + 3) * 65 + n]);
    a.z = pack2(t[(kq + 4) * 65 + n], t[(kq + 5) * 65 + n]); a.w = pack2(t[(kq + 6) * 65 + n], t[(kq + 7) * 65 + n]);
    b.x = pack2(t[(kq + 8) * 65 + n], t[(kq + 9) * 65 + n]); b.y = pack2(t[(kq + 10) * 65 + n], t[(kq + 11) * 65 + n]);
    b.z = pack2(t[(kq + 12) * 65 + n], t[(kq + 13) * 65 + n]); b.w = pack2(t[(kq + 14) * 65 + n], t[(kq + 15) * 65 + n]);
    bf16_t* d = dst + (size_t)(n0 + n) * K + k0 + kq;
    *(uint4*)d = a; *(uint4*)(d + 8) = b;
  }
  __syncthreads();
}
constexpr int P0_J0 = 54 * 16, P0_J1 = P0_J0 + 256, P0_J2 = P0_J1 + 28 * 16, P0_J3 = P0_J2 + 24 * 6, P0_J4 = P0_J3 + 32 * 4,
              P0_J5 = P0_J4 + 256, P0_J6 = P0_J5 + 2 * 2 * 32, P0_J7 = P0_J6 + 2 * 2, P0_J8 = P0_J7 + 16, P0_TOTAL = P0_J8 + 4096;
DI void p0_task(const Params& p, char* smem, int idx) {
  char* ws = p.ws;
  const int tid = threadIdx.x;
  if (idx < P0_J0) { prep_tile(smem, (bf16_t*)(ws + OFF_WT_IN0), 1024, p.e_w_in, 3368, 1, nullptr, (idx >> 4) * 64, (idx & 15) * 64); return; }
  if (idx < P0_J1) { int t = idx - P0_J0; prep_tile(smem, (bf16_t*)(ws + OFF_WT_OUT0), 1024, p.e_w_out, 1024, 0, nullptr, (t >> 4) * 64, (t & 15) * 64); return; }
  if (idx < P0_J2) { int t = idx - P0_J1; prep_tile(smem, (bf16_t*)(ws + OFF_WT_IN1), 1024, p.o_w_in, 1696, 2, nullptr, (t >> 4) * 64, (t & 15) * 64); return; }
  if (idx < P0_J3) { int t = idx - P0_J2; prep_tile(smem, (bf16_t*)(ws + OFF_WT_UQ), 384, p.o_w_uq, 1536, 0, p.o_q_norm, (t / 6) * 64, (t % 6) * 64); return; }
  if (idx < P0_J4) { int t = idx - P0_J3; prep_tile(smem, (bf16_t*)(ws + OFF_WT_UKV), 256, p.o_w_ukv, 2048, 3, p.o_kv_norm, (t >> 2) * 64, (t & 3) * 64); return; }
  if (idx < P0_J5) { int t = idx - P0_J4; prep_tile(smem, (bf16_t*)(ws + OFF_WT_OUT1), 1024, p.o_w_out, 1024, 0, nullptr, (t >> 4) * 64, (t & 15) * 64); return; }
  if (idx < P0_J6) { int t = idx - P0_J5; int j = t >> 6; t &= 63; prep_tile(smem, (bf16_t*)(ws + OFF_W1T) + (size_t)j * 128 * 2048, 2048, p.e_cmp_w1 + (size_t)j * 2048 * 128, 128, 0, nullptr, (t >> 5) * 64, (t & 31) * 64); return; }
  if (idx < P0_J7) { int t = idx - P0_J6; int j = t >> 1; prep_tile(smem, (bf16_t*)(ws + OFF_W2T) + (size_t)j * 64 * 128, 128, p.e_cmp_w2 + (size_t)j * 128 * 64, 64, 0, nullptr, 0, (t & 1) * 64); return; }
  if (idx < P0_J8) {
    int t = idx - P0_J7; int j = t >> 3, mg = t & 7;
    int m = mg * 16 + (tid & 15), ks = tid >> 4;
    const float* pe = p.e_cmp_pe + (size_t)j * 2048; const float* w1 = p.e_cmp_w1 + (size_t)j * 2048 * 128;
    float acc = 0.f;
    for (int kk = ks * 128; kk < ks * 128 + 128; kk++) acc += pe[kk] * w1[(size_t)kk * 128 + m];
    float* red = (float*)smem;
    red[tid] = acc;
    __syncthreads();
    if (tid < 16) { float s = 0.f; for (int q = 0; q < 16; q++) s += red[q * 16 + tid]; ((float*)(ws + OFF_BIAS1))[j * 128 + mg * 16 + tid] = s; }
    __syncthreads();
    return;
  }
  {
    int t = idx - P0_J8;
    float4 a[4], b[4];
#pragma unroll
    for (int q = 0; q < 4; q++) { size_t e = ((size_t)(t * 4 + q) * 256 + tid) * 8; a[q] = *(const float4*)(p.x + e); b[q] = *(const float4*)(p.x + e + 4); }
#pragma unroll
    for (int q = 0; q < 4; q++) {
      size_t e = ((size_t)(t * 4 + q) * 256 + tid) * 8;
      uint4 o; o.x = pack2(a[q].x, a[q].y); o.y = pack2(a[q].z, a[q].w); o.z = pack2(b[q].x, b[q].y); o.w = pack2(b[q].z, b[q].w);
      *(uint4*)((bf16_t*)(ws + OFF_REGD) + e) = o;
    }
  }
}

constexpr int P1_TOTAL = 256 * 27;
DI void p1_tile(const Params& p, char* smem, int tm, int tn) {
  char* ws = p.ws;
  const int tid = threadIdx.x, lane = tid & 63, w = __builtin_amdgcn_readfirstlane(tid >> 6), wp = w >> 1, wq = w & 1, r = lane & 31, h = lane >> 5;
  SrcRM sx{(const bf16_t*)(ws + OFF_REGD), 1024}, sw{(const bf16_t*)(ws + OFF_WT_IN0), 1024};
  bf16_t* H0 = (bf16_t*)(ws + OFF_REGB);
  f32x16 acc[2][2];
  const int t0 = tm * 128, n0 = tn * 128;
  const bool tr = (tn == 7 || tn == 9 || (tn >= 18 && tn < 22));
  gemm_tile<2, 2>(smem, tr ? sx : sw, tr ? t0 : n0, tr ? sw : sx, tr ? n0 : t0, 1024, acc);
  if (!tr) {
    epi_store_bf16(smem, acc, H0 + (size_t)t0 * H0LD + n0, H0LD, H0LD - n0);
  } else {
    bf16_t* dst; int c0, NC;
    if (tn == 7) { dst = (bf16_t*)(ws + OFF_VTNSA); c0 = 0; NC = 256; }
    else if (tn == 9) { dst = (bf16_t*)(ws + OFF_VTNSA); c0 = 128; NC = 256; }
    else { dst = (bf16_t*)(ws + OFF_VTGLA); c0 = (tn - 18) * 128; NC = 512; }
    const int b = t0 >> 11, s0 = t0 & 2047;
    epi_store_bf16(smem, acc, dst + ((size_t)(b * NC + c0)) * 2048 + s0, 2048, 128);
  }
}

constexpr int P2_TOTAL = 128;
DI void p2_task(const Params& p, char* smem, int idx) {
  char* ws = p.ws;
  const int half = idx & 1, j = (idx >> 1) & 1, g = (idx >> 2) & 1, b = idx >> 3;
  const int tid = threadIdx.x, lane = tid & 63, w = __builtin_amdgcn_readfirstlane(tid >> 6), wp = w >> 1, wq = w & 1, r = lane & 31, h = lane >> 5;
  const bf16_t* H0 = (const bf16_t*)(ws + OFF_REGB);
  SrcCmp sa{H0 + (size_t)b * 2048 * H0LD + 512 + j * 128 + g * 64};
  SrcRM sw{(const bf16_t*)(ws + OFF_W1T) + (size_t)j * 128 * 2048, 2048};
  f32x16 acc[1][2];
  gemm_tile<1, 2>(smem, sa, half * 64, sw, 0, 2048, acc);
  const float* bias = (const float*)(ws + OFF_BIAS1) + j * 128;
  char* sH = smem; char* sW = smem + 64 * 272;
#pragma unroll
  for (int iq = 0; iq < 2; iq++) {
    int m = (wq * 2 + iq) * 32 + r; float bm = bias[m];
#pragma unroll
    for (int i = 0; i < 16; i++) {
      int nl = wp * 32 + crow(i, h);
      ((bf16_t*)(sH + nl * 272))[m] = (bf16_t)f2bf(silu(acc[0][iq][i] + bm));
    }
  }
  const bf16_t* W2T = (const bf16_t*)(ws + OFF_W2T) + (size_t)j * 64 * 128;
#pragma unroll
  for (int i = 0; i < 4; i++) { int c = tid + 256 * i; int row = c >> 4, kc = c & 15; *(uint4*)(sW + row * 272 + kc * 16) = *(const uint4*)(W2T + row * 128 + kc * 8); }
  __syncthreads();
  f32x16 o;
#pragma unroll
  for (int i = 0; i < 16; i++) o[i] = 0.f;
  if (j == 0) {
#pragma unroll
    for (int s = 0; s < 8; s++) {
      bf16x8 a = *(const bf16x8*)(sW + (wp * 32 + r) * 272 + s * 32 + h * 16);
      bf16x8 bq = *(const bf16x8*)(sH + (wq * 32 + r) * 272 + s * 32 + h * 16);
      o = MFMA32(a, bq, o);
    }
    bf16_t* KC = (bf16_t*)(ws + OFF_KCMP);
    int n = half * 64 + wq * 32 + r;
#pragma unroll
    for (int gg = 0; gg < 4; gg++)
      *(uint2*)(KC + ((size_t)((b * 2 + g) * 128 + n)) * 64 + wp * 32 + 8 * gg + 4 * h) = pack4(o[4 * gg], o[4 * gg + 1], o[4 * gg + 2], o[4 * gg + 3]);
  } else {
#pragma unroll
    for (int s = 0; s < 8; s++) {
      bf16x8 a = *(const bf16x8*)(sH + (wp * 32 + r) * 272 + s * 32 + h * 16);
      bf16x8 bq = *(const bf16x8*)(sW + (wq * 32 + r) * 272 + s * 32 + h * 16);
      o = MFMA32(a, bq, o);
    }
    bf16_t* VC = (bf16_t*)(ws + OFF_VCMPT);
    int d = wq * 32 + r;
#pragma unroll
    for (int gg = 0; gg < 4; gg++)
      *(uint2*)(VC + ((size_t)((b * 2 + g) * 64 + d)) * 128 + half * 64 + wp * 32 + 8 * gg + 4 * h) = pack4(o[4 * gg], o[4 * gg + 1], o[4 * gg + 2], o[4 * gg + 3]);
  }
  __syncthreads();
}

template <int DQK, bool ALIBI, class KP, class VP, class NM, class VIS>
DI void attn_loop(const int tid, char* smem, const bf16x8 (&qf)[DQK / 16], int jlo, int jhi, unsigned tmask, int wave_jhi, KP kp, VP vp,
                  const float c1, const float slope2, const int tq, NM needmask, VIS vis, f32x16 (&o)[2], float& m, float& l) {
  constexpr int KROW = DQK * 2 + 16, KSZ = 64 * KROW, STG = KSZ + 64 * LDS_ROW, KCH = DQK / 8, NKC = KCH / 4;
  const int lane = tid & 63, r = lane & 31, h = lane >> 5;
  u32x4 rk[NKC], rv[2];
  auto nexttile = [&](int from) { while (from <= jhi && !((tmask >> from) & 1u)) from++; return from <= jhi ? from : -1; };
#define ATT_GLOAD(JT) { _Pragma("unroll") for (int i = 0; i < NKC; i++) { int c = tid + 256 * i; int row = c / KCH, kc = c % KCH; rk[i] = *(const u32x4*)kp((JT) * 64 + row, kc); } \
    _Pragma("unroll") for (int i = 0; i < 2; i++) { int c = tid + 256 * i; int row = c >> 3, kc = c & 7; rv[i] = *(const u32x4*)vp(row, (JT) * 64 + kc * 8); } }
#define ATT_SSTORE(ST) { char* st_ = (ST); _Pragma("unroll") for (int i = 0; i < NKC; i++) { int c = tid + 256 * i; int row = c / KCH, kc = c % KCH; *(u32x4*)(st_ + row * KROW + kc * 16) = rk[i]; } \
    _Pragma("unroll") for (int i = 0; i < 2; i++) { int c = tid + 256 * i; int row = c >> 3, kc = c & 7; *(u32x4*)(st_ + KSZ + row * LDS_ROW + kc * 16) = rv[i]; } }
  int jt = nexttile(jlo);
  if (jt < 0) return;
  ATT_GLOAD(jt); ATT_SSTORE(smem);
  int jn = nexttile(jt + 1);
  if (jn >= 0) ATT_GLOAD(jn);
  int stg = 0;
  while (true) {
    __syncthreads();
    int jnn = -1;
    if (jn >= 0) { ATT_SSTORE(smem + (stg ^ 1) * STG); jnn = nexttile(jn + 1); if (jnn >= 0) ATT_GLOAD(jnn); }
    __builtin_amdgcn_sched_barrier(0);
    if (jt <= wave_jhi) {
      const char* sK = smem + stg * STG; const char* sV = sK + KSZ;
      f32x16 st[2];
#pragma unroll
      for (int kt = 0; kt < 2; kt++)
#pragma unroll
        for (int i = 0; i < 16; i++) st[kt][i] = 0.f;
#pragma unroll
      for (int s = 0; s < DQK / 16; s++)
#pragma unroll
        for (int kt = 0; kt < 2; kt++) {
          bf16x8 a = *(const bf16x8*)(sK + (32 * kt + r) * KROW + s * 32 + h * 16);
          st[kt] = MFMA32(a, qf[s], st[kt]);
        }
      const bool nmask = needmask(jt);
      float mx = -INFINITY, muse, mnew;
      if (ALIBI) {
        const float tb = slope2 * (float)(jt * 64 + 4 * h - tq);
#pragma unroll
        for (int kt = 0; kt < 2; kt++)
#pragma unroll
          for (int i = 0; i < 16; i++) st[kt][i] = fmaf(st[kt][i], c1, fmaf(slope2, (float)(32 * kt + (i & 3) + 8 * (i >> 2)), tb));
      }
      if (nmask) {
#pragma unroll
        for (int kt = 0; kt < 2; kt++)
#pragma unroll
          for (int i = 0; i < 16; i++) st[kt][i] = vis(jt * 64 + 32 * kt + crow(i, h), jt) ? st[kt][i] : -INFINITY;
      }
#pragma unroll
      for (int kt = 0; kt < 2; kt++)
#pragma unroll
        for (int i = 0; i < 16; i++) mx = fmaxf(mx, st[kt][i]);
      if (!ALIBI) mx *= c1;
      mx = fmaxf(mx, __shfl_xor(mx, 32));
      mnew = fmaxf(m, mx);
      if (__builtin_amdgcn_ballot_w64(mnew > m + 8.f) != 0) {
        float alpha = (mnew == m) ? 1.f : fexp2(m - mnew);
        l *= alpha;
#pragma unroll
        for (int dt = 0; dt < 2; dt++)
#pragma unroll
          for (int i = 0; i < 16; i++) o[dt][i] *= alpha;
        m = mnew;
      }
      muse = (m == -INFINITY) ? 0.f : m;
      float ps = 0.f;
      const float nm = -muse;
#pragma unroll
      for (int kt = 0; kt < 2; kt++)
#pragma unroll
        for (int i = 0; i < 16; i++) { float pv = ALIBI ? fexp2(st[kt][i] + nm) : fexp2(fmaf(st[kt][i], c1, nm)); st[kt][i] = pv; ps += pv; }
      l += ps;
#pragma unroll
      for (int kt = 0; kt < 2; kt++)
#pragma unroll
        for (int s2 = 0; s2 < 2; s2++) {
          bf16x8 pf = pack8(st[kt], 8 * s2);
#pragma unroll
          for (int dt = 0; dt < 2; dt++) {
            bf16x8 vf = ld2x8(sV + (32 * dt + r) * LDS_ROW + (32 * kt + 16 * s2 + 4 * h) * 2);
            o[dt] = MFMA32(vf, pf, o[dt]);
          }
        }
    }
    if (jn < 0) break;
    jt = jn; jn = jnn; stg ^= 1;
  }
  __syncthreads();
}

constexpr int NSA_TASKS = 16 * 2 * 64;
DI void nsa_task(const Params& p, char* smem, int idx) {
  char* ws = p.ws;
  const int qb = 63 - (idx >> 5), g = idx & 1, b = (idx >> 1) & 15;
  int tid_ = threadIdx.x; asm volatile("" : "+v"(tid_));
  const int tid = tid_, lane = tid & 63, w = __builtin_amdgcn_readfirstlane(tid >> 6), r = lane & 31, h = lane >> 5;
  const int hq = g * 4 + w;
  const float slope2 = exp2f(-(float)(hq + 1)) * LOG2E;
  const float c1 = 0.125f * LOG2E;
  const int t = qb * 32 + r;
  const size_t tok = (size_t)b * 2048 + t;
  const bf16_t* H0 = (const bf16_t*)(ws + OFF_REGB);
  bf16x8 qf[4];
#pragma unroll
  for (int s = 0; s < 4; s++) qf[s] = *(const bf16x8*)(H0 + tok * H0LD + hq * 64 + 16 * s + 8 * h);
  float gate[3];
#pragma unroll
  for (int br = 0; br < 3; br++) { float gl = bf2f(H0[tok * H0LD + 3328 + br * 8 + hq]); gate[br] = 1.f / (1.f + __expf(-gl)); }
  f32x16 tot[2];
  float* impw = (float*)(smem + 36864);
  unsigned* selmask = (unsigned*)(smem + 36864 + 16896);
  unsigned* umaskp = selmask + 32;
  const int cur = qb >> 1;
  {
    const bf16_t* KC = (const bf16_t*)(ws + OFF_KCMP) + (size_t)(b * 2 + g) * 128 * 64;
    const bf16_t* VC = (const bf16_t*)(ws + OFF_VCMPT) + (size_t)(b * 2 + g) * 64 * 128;
    char* sK = smem; char* sV = smem + 18432;
#pragma unroll
    for (int i = 0; i < 4; i++) { int c = tid + 256 * i; int row = c >> 3, kc = c & 7; *(uint4*)(sK + row * LDS_ROW + kc * 16) = *(const uint4*)(KC + row * 64 + kc * 8); }
#pragma unroll
    for (int i = 0; i < 4; i++) { int c = tid + 256 * i; int row = c >> 4, kc = c & 15; *(uint4*)(sV + row * 272 + kc * 16) = *(const uint4*)(VC + row * 128 + kc * 8); }
    if (tid < 32) selmask[tid] = 0u;
    if (tid == 32) *umaskp = 0u;
    __syncthreads();
    f32x16 st[4];
#pragma unroll
    for (int kt = 0; kt < 4; kt++)
#pragma unroll
      for (int i = 0; i < 16; i++) st[kt][i] = 0.f;
#pragma unroll
    for (int s = 0; s < 4; s++)
#pragma unroll
      for (int kt = 0; kt < 4; kt++) {
        bf16x8 a = *(const bf16x8*)(sK + (32 * kt + r) * LDS_ROW + s * 32 + h * 16);
        st[kt] = MFMA32(a, qf[s], st[kt]);
      }
    float mx = -INFINITY;
#pragma unroll
    for (int kt = 0; kt < 4; kt++)
#pragma unroll
      for (int i = 0; i < 16; i++) {
        int n = 32 * kt + crow(i, h);
        int dist = t - (16 * n + 31);
        float v = (dist >= 0 && n < 127) ? st[kt][i] * c1 - slope2 * (float)dist : -INFINITY;
        st[kt][i] = v; mx = fmaxf(mx, v);
      }
    mx = fmaxf(mx, __shfl_xor(mx, 32));
    float muse = (mx == -INFINITY) ? 0.f : mx;
    float ps = 0.f;
#pragma unroll
    for (int kt = 0; kt < 4; kt++)
#pragma unroll
      for (int i = 0; i < 16; i++) { float pv = fexp2(st[kt][i] - muse); st[kt][i] = pv; ps += pv; }
    ps += __shfl_xor(ps, 32);
    float inv = ps > 0.f ? 1.f / ps : 0.f;
#pragma unroll
    for (int kt = 0; kt < 4; kt++)
#pragma unroll
      for (int i = 0; i < 16; i++) st[kt][i] *= inv;
    {
      float prev = 0.f;
#pragma unroll
      for (int f = 0; f < 16; f++) {
        const int kt = f >> 2, gg = f & 3;
        float p3 = 0.5f * st[kt][4 * gg + 3];
        float mainv = st[kt][4 * gg] + st[kt][4 * gg + 1] + st[kt][4 * gg + 2] + p3;
        float rc = __shfl_xor(p3, 32);
        mainv += (h == 1) ? rc : prev;
        prev = rc;
        impw[(w * 32 + r) * 33 + 2 * f + h] = mainv;
      }
    }
#pragma unroll
    for (int dt = 0; dt < 2; dt++)
#pragma unroll
      for (int i = 0; i < 16; i++) tot[dt][i] = 0.f;
#pragma unroll
    for (int kt = 0; kt < 4; kt++)
#pragma unroll
      for (int s2 = 0; s2 < 2; s2++) {
        bf16x8 pf = pack8(st[kt], 8 * s2);
#pragma unroll
        for (int dt = 0; dt < 2; dt++) {
          bf16x8 vf = ld2x8(sV + (32 * dt + r) * 272 + (32 * kt + 16 * s2 + 4 * h) * 2);
          tot[dt] = MFMA32(vf, pf, tot[dt]);
        }
      }
#pragma unroll
    for (int dt = 0; dt < 2; dt++)
#pragma unroll
      for (int i = 0; i < 16; i++) tot[dt][i] *= gate[0];
    __syncthreads();
    {
      int q = tid >> 3, jq = tid & 7;
#pragma unroll
      for (int e = 0; e < 4; e++) {
        int j = jq * 4 + e;
        float s = impw[(0 * 32 + q) * 33 + j] + impw[(1 * 32 + q) * 33 + j] + impw[(2 * 32 + q) * 33 + j] + impw[(3 * 32 + q) * 33 + j];
        impw[q * 33 + j] = s;
      }
    }
    __syncthreads();
    {
      int q = tid >> 3, jq = tid & 7;
      int nforced = cur == 0 ? 1 : (cur == 1 ? 2 : 3);
      unsigned bits = 0u;
#pragma unroll
      for (int e = 0; e < 4; e++) {
        int j = jq * 4 + e;
        if (j > cur) continue;
        bool forced = (j == 0) || (j == cur) || (j == cur - 1);
        if (forced) { bits |= 1u << j; continue; }
        float v = impw[q * 33 + j];
        int rank = 0;
        for (int j2 = 1; j2 < cur - 1; j2++) {
          float v2 = impw[q * 33 + j2];
          rank += (v2 > v || (v2 == v && j2 < j)) ? 1 : 0;
        }
        if (nforced + rank < 8) bits |= 1u << j;
      }
      if (bits) { atomicOr(&selmask[q], bits); atomicOr(umaskp, bits); }
    }
    __syncthreads();
  }
  const unsigned mysel = selmask[r];
  const unsigned umask = *umaskp;
  unsigned allsel_v = mysel;
#pragma unroll
  for (int off = 16; off >= 1; off >>= 1) allsel_v &= (unsigned)__shfl_xor((int)allsel_v, off);
  const unsigned allsel = __builtin_amdgcn_readfirstlane(allsel_v);
  __syncthreads();
  {
    f32x16 o[2];
#pragma unroll
    for (int dt = 0; dt < 2; dt++)
#pragma unroll
      for (int i = 0; i < 16; i++) o[dt][i] = 0.f;
    float m = -INFINITY, l = 0.f;
    const bf16_t* Kb = H0 + (size_t)b * 2048 * H0LD + 768 + g * 64;
    const bf16_t* Vb = (const bf16_t*)(ws + OFF_VTNSA) + ((size_t)(b * 256 + g * 64)) * 2048;
    attn_loop<64, true>(tid, smem, qf, 0, cur, umask, cur,
                  [&](int key, int kc) { return Kb + (size_t)key * H0LD + kc * 8; },
                  [&](int row, int key) { return Vb + (size_t)row * 2048 + key; },
                  c1, slope2, t,
                  [&](int jt) { return !((allsel >> jt) & 1u) || (jt * 64 + 63 > qb * 32); },
                  [&](int key, int jt) { return ((mysel >> jt) & 1u) && key <= t; },
                  o, m, l);
    l += __shfl_xor(l, 32);
    float sc = l > 0.f ? gate[1] / l : 0.f;
#pragma unroll
    for (int dt = 0; dt < 2; dt++)
#pragma unroll
      for (int i = 0; i < 16; i++) tot[dt][i] += sc * o[dt][i];
  }
  {
    f32x16 o[2];
#pragma unroll
    for (int dt = 0; dt < 2; dt++)
#pragma unroll
      for (int i = 0; i < 16; i++) o[dt][i] = 0.f;
    float m = -INFINITY, l = 0.f;
    const bf16_t* Kb = H0 + (size_t)b * 2048 * H0LD + 1024 + g * 64;
    const bf16_t* Vb = (const bf16_t*)(ws + OFF_VTNSA) + ((size_t)(b * 256 + 128 + g * 64)) * 2048;
    int lo = qb * 32 - 511; lo = lo < 0 ? 0 : (lo >> 6);
    attn_loop<64, true>(tid, smem, qf, lo, cur, 0xffffffffu, cur,
                  [&](int key, int kc) { return Kb + (size_t)key * H0LD + kc * 8; },
                  [&](int row, int key) { return Vb + (size_t)row * 2048 + key; },
                  c1, slope2, t,
                  [&](int jt) { return (qb * 32 + 31 - 64 * jt > 511) || (qb * 32 - 64 * jt - 63 < 0); },
                  [&](int key, int jt) { int dist = t - key; return dist >= 0 && dist < 512; },
                  o, m, l);
    l += __shfl_xor(l, 32);
    float sc = l > 0.f ? gate[2] / l : 0.f;
#pragma unroll
    for (int dt = 0; dt < 2; dt++)
#pragma unroll
      for (int i = 0; i < 16; i++) tot[dt][i] += sc * o[dt][i];
  }
  bf16_t* CAT = (bf16_t*)(ws + OFF_REGD);
#pragma unroll
  for (int dt = 0; dt < 2; dt++)
#pragma unroll
    for (int gg = 0; gg < 4; gg++) {
      int dv = 32 * dt + 8 * gg + 4 * h;
      uint2 z = *(const uint2*)(H0 + tok * H0LD + 1280 + hq * 64 + dv);
      *(uint2*)(CAT + tok * 1024 + hq * 64 + dv) =
          pack4(tot[dt][4 * gg] * silu(bflo(z.x)), tot[dt][4 * gg + 1] * silu(bfhi(z.x)), tot[dt][4 * gg + 2] * silu(bflo(z.y)), tot[dt][4 * gg + 3] * silu(bfhi(z.y)));
    }
}

constexpr int GLA_CHUNK_TASKS = 2048;
DI void gla_a_task(const Params& p, char* smem, int idx) {
  char* ws = p.ws;
  const int chunk = idx & 31, hh = (idx >> 5) & 3, b = idx >> 7;
  int tid_ = threadIdx.x; asm volatile("" : "+v"(tid_));
  const int tid = tid_, lane = tid & 63, w = __builtin_amdgcn_readfirstlane(tid >> 6), r = lane & 31, h = lane >> 5;
  const bf16_t* H0 = (const bf16_t*)(ws + OFF_REGB);
  const bf16_t* VT = (const bf16_t*)(ws + OFF_VTGLA) + ((size_t)(b * 512 + hh * 128)) * 2048;
  char* sQ = smem; char* sK = smem + 9216; char* sKKT = smem + 18432; char* sVT = smem + 27648;
  float* sTot = (float*)(smem + 46080); float* sB = (float*)(smem + 46080 + 1280);
  const int d = tid & 63, cq = w;
  const size_t tok0 = (size_t)b * 2048 + chunk * 64;
  uint4 vreg[4];
#pragma unroll
  for (int i = 0; i < 4; i++) { int c = tid + 256 * i; int row = c >> 3, kc = c & 7; vreg[i] = *(const uint4*)(VT + (size_t)row * 2048 + chunk * 64 + kc * 8); }
  float wg[16];
#pragma unroll
  for (int q = 0; q < 16; q++) wg[q] = p.e_gla_w_gate[q * 256 + hh * 64 + d];
  const float bg = p.e_gla_b_gate[hh * 64 + d];
  float cum[16]; float run = 0.f;
#pragma unroll
  for (int i = 0; i < 16; i++) {
    const bf16_t* gl = H0 + (tok0 + cq * 16 + i) * H0LD + 3360;
    uint4 g0 = *(const uint4*)gl, g1 = *(const uint4*)(gl + 8);
    float a = bg;
    a += bflo(g0.x) * wg[0] + bfhi(g0.x) * wg[1] + bflo(g0.y) * wg[2] + bfhi(g0.y) * wg[3];
    a += bflo(g0.z) * wg[4] + bfhi(g0.z) * wg[5] + bflo(g0.w) * wg[6] + bfhi(g0.w) * wg[7];
    a += bflo(g1.x) * wg[8] + bfhi(g1.x) * wg[9] + bflo(g1.y) * wg[10] + bfhi(g1.y) * wg[11];
    a += bflo(g1.z) * wg[12] + bfhi(g1.z) * wg[13] + bflo(g1.w) * wg[14] + bfhi(g1.w) * wg[15];
    float ls = fminf(a, 0.f) - __logf(1.f + __expf(-fabsf(a)));
    run += ls * (1.f / 16.f);
    cum[i] = run;
  }
  sTot[cq * 64 + d] = run;
  bf16_t qraw[16], kraw[16];
#pragma unroll
  for (int i = 0; i < 16; i++) { size_t tk = tok0 + cq * 16 + i; qraw[i] = H0[tk * H0LD + 1792 + hh * 64 + d]; kraw[i] = H0[tk * H0LD + 2048 + hh * 64 + d]; }
#pragma unroll
  for (int i = 0; i < 4; i++) { int c = tid + 256 * i; int row = c >> 3, kc = c & 7; *(uint4*)(sVT + row * LDS_ROW + kc * 16) = vreg[i]; }
  __syncthreads();
  {
    float t0 = sTot[d], t1 = sTot[64 + d], t2 = sTot[128 + d], t3 = sTot[192 + d];
    float off = cq == 0 ? 0.f : cq == 1 ? t0 : cq == 2 ? t0 + t1 : t0 + t1 + t2;
    float blast = t0 + t1 + t2 + t3;
    bf16_t* QD = (bf16_t*)(ws + OFF_QD);
#pragma unroll
    for (int i = 0; i < 16; i++) {
      int c = cq * 16 + i;
      float bb = cum[i] + off;
      float qv = bf2f(qraw[i]), kv = bf2f(kraw[i]);
      bf16_t qd = (bf16_t)f2bf(qv * 0.125f * __expf(bb));
      ((bf16_t*)(sQ + c * LDS_ROW))[d] = qd;
      QD[(tok0 + c) * 256 + hh * 64 + d] = qd;
      ((bf16_t*)(sK + c * LDS_ROW))[d] = (bf16_t)f2bf(kv * __expf(-bb));
      ((bf16_t*)(sKKT + d * LDS_ROW))[c] = (bf16_t)f2bf(kv * __expf(blast - bb));
    }
    if (cq == 0) ((float*)(ws + OFF_DEC))[(size_t)idx * 64 + d] = __expf(blast);
  }
  __syncthreads();
  f32x16 at0, at1, at2;
#pragma unroll
  for (int i = 0; i < 16; i++) { at0[i] = 0.f; at1[i] = 0.f; at2[i] = 0.f; }
#pragma unroll
  for (int s = 0; s < 4; s++) {
    bf16x8 k0 = *(const bf16x8*)(sK + (r)*LDS_ROW + s * 32 + h * 16);
    bf16x8 k1 = *(const bf16x8*)(sK + (32 + r) * LDS_ROW + s * 32 + h * 16);
    bf16x8 q0 = *(const bf16x8*)(sQ + (r)*LDS_ROW + s * 32 + h * 16);
    bf16x8 q1 = *(const bf16x8*)(sQ + (32 + r) * LDS_ROW + s * 32 + h * 16);
    at0 = MFMA32(k0, q0, at0); at1 = MFMA32(k0, q1, at1); at2 = MFMA32(k1, q1, at2);
  }
#pragma unroll
  for (int i = 0; i < 16; i++) { if (r < crow(i, h)) { at0[i] = 0.f; at2[i] = 0.f; } }
  f32x16 o[2], U[2];
#pragma unroll
  for (int c2 = 0; c2 < 2; c2++)
#pragma unroll
    for (int i = 0; i < 16; i++) { o[c2][i] = 0.f; U[c2][i] = 0.f; }
#pragma unroll
  for (int s2 = 0; s2 < 2; s2++) {
    bf16x8 v0 = ld2x8(sVT + (32 * w + r) * LDS_ROW + (0 + 16 * s2 + 4 * h) * 2);
    bf16x8 v1 = ld2x8(sVT + (32 * w + r) * LDS_ROW + (32 + 16 * s2 + 4 * h) * 2);
    o[0] = MFMA32(pack8(at0, 8 * s2), v0, o[0]);
    o[1] = MFMA32(pack8(at1, 8 * s2), v0, o[1]);
    o[1] = MFMA32(pack8(at2, 8 * s2), v1, o[1]);
  }
#pragma unroll
  for (int dT = 0; dT < 2; dT++)
#pragma unroll
    for (int s4 = 0; s4 < 4; s4++) {
      bf16x8 a = *(const bf16x8*)(sKKT + (32 * dT + r) * LDS_ROW + s4 * 32 + h * 16);
      bf16x8 bq = *(const bf16x8*)(sVT + (32 * w + r) * LDS_ROW + s4 * 32 + h * 16);
      U[dT] = MFMA32(a, bq, U[dT]);
    }
  bf16_t* OI = (bf16_t*)(ws + OFF_OI);
  const int dv = 32 * w + r;
#pragma unroll
  for (int c2 = 0; c2 < 2; c2++)
#pragma unroll
    for (int i = 0; i < 16; i++) OI[(tok0 + 32 * c2 + crow(i, h)) * 512 + hh * 128 + dv] = (bf16_t)f2bf(o[c2][i]);
  float* UPD = (float*)(ws + OFF_UPD) + ((size_t)idx * 128 + dv) * 64;
#pragma unroll
  for (int dT = 0; dT < 2; dT++)
#pragma unroll
    for (int gg = 0; gg < 4; gg++) {
      float4 u; u.x = U[dT][4 * gg]; u.y = U[dT][4 * gg + 1]; u.z = U[dT][4 * gg + 2]; u.w = U[dT][4 * gg + 3];
      *(float4*)(UPD + 32 * dT + 8 * gg + 4 * h) = u;
    }
  __syncthreads();
}

constexpr int GLA_B_TASKS = 512;
DI void gla_b_task(const Params& p, int idx) {
  char* ws = p.ws;
  const int gid = idx * 256 + threadIdx.x;
  const int bh = gid >> 11, dv = (gid >> 4) & 127, dq = gid & 15;
  const float* UPD = (const float*)(ws + OFF_UPD) + ((size_t)bh * 32 * 128 + dv) * 64 + dq * 4;
  const float* DEC = (const float*)(ws + OFF_DEC) + (size_t)bh * 32 * 64 + dq * 4;
  bf16_t* ST = (bf16_t*)(ws + OFF_ST) + ((size_t)bh * 32 * 128 + dv) * 64 + dq * 4;
  float4 s = {0.f, 0.f, 0.f, 0.f};
#pragma unroll 1
  for (int n0 = 0; n0 < 32; n0 += 8) {
    float4 u[8], dc[8];
#pragma unroll
    for (int q = 0; q < 8; q++) { u[q] = *(const float4*)(UPD + (size_t)(n0 + q) * 128 * 64); dc[q] = *(const float4*)(DEC + (n0 + q) * 64); }
#pragma unroll
    for (int q = 0; q < 8; q++) {
      *(uint2*)(ST + (size_t)(n0 + q) * 128 * 64) = pack4(s.x, s.y, s.z, s.w);
      s.x = dc[q].x * s.x + u[q].x; s.y = dc[q].y * s.y + u[q].y; s.z = dc[q].z * s.z + u[q].z; s.w = dc[q].w * s.w + u[q].w;
    }
  }
}

DI void gla_c_task(const Params& p, char* smem, int idx) {
  char* ws = p.ws;
  const int chunk = idx & 31, hh = (idx >> 5) & 3, b = idx >> 7;
  int tid_ = threadIdx.x; asm volatile("" : "+v"(tid_));
  const int tid = tid_, lane = tid & 63, w = __builtin_amdgcn_readfirstlane(tid >> 6), r = lane & 31, h = lane >> 5;
  const bf16_t* H0 = (const bf16_t*)(ws + OFF_REGB);
  const bf16_t* QD = (const bf16_t*)(ws + OFF_QD);
  const bf16_t* ST = (const bf16_t*)(ws + OFF_ST) + (size_t)idx * 128 * 64;
  const bf16_t* OI = (const bf16_t*)(ws + OFF_OI);
  bf16_t* CAT = (bf16_t*)(ws + OFF_REGD);
  char* sQ = smem; char* sS = smem + 9216; float* sO = (float*)(smem + 27648);
  const size_t tok0 = (size_t)b * 2048 + chunk * 64;
#pragma unroll
  for (int i = 0; i < 2; i++) { int c = tid + 256 * i; int row = c >> 3, kc = c & 7; *(uint4*)(sQ + row * LDS_ROW + kc * 16) = *(const uint4*)(QD + (tok0 + row) * 256 + hh * 64 + kc * 8); }
#pragma unroll
  for (int i = 0; i < 4; i++) { int c = tid + 256 * i; int row = c >> 3, kc = c & 7; *(uint4*)(sS + row * LDS_ROW + kc * 16) = *(const uint4*)(ST + row * 64 + kc * 8); }
  const int dv = 32 * w + r;
  float oi[2][16];
#pragma unroll
  for (int c2 = 0; c2 < 2; c2++)
#pragma unroll
    for (int i = 0; i < 16; i++) oi[c2][i] = bf2f(OI[(tok0 + 32 * c2 + crow(i, h)) * 512 + hh * 128 + dv]);
  __syncthreads();
  f32x16 o[2];
#pragma unroll
  for (int c2 = 0; c2 < 2; c2++)
#pragma unroll
    for (int i = 0; i < 16; i++) o[c2][i] = oi[c2][i];
#pragma unroll
  for (int s = 0; s < 4; s++) {
    bf16x8 bq = *(const bf16x8*)(sS + (32 * w + r) * LDS_ROW + s * 32 + h * 16);
#pragma unroll
    for (int c2 = 0; c2 < 2; c2++) {
      bf16x8 a = *(const bf16x8*)(sQ + (32 * c2 + r) * LDS_ROW + s * 32 + h * 16);
      o[c2] = MFMA32(a, bq, o[c2]);
    }
  }
#pragma unroll
  for (int c2 = 0; c2 < 2; c2++)
#pragma unroll
    for (int i = 0; i < 16; i++) sO[(32 * c2 + crow(i, h)) * 129 + dv] = o[c2][i];
  __syncthreads();
  {
    int c = tid >> 2, part = tid & 3; size_t tk = tok0 + c;
    float ssq = 0.f;
#pragma unroll
    for (int i4 = 0; i4 < 4; i4++)
#pragma unroll
      for (int e = 0; e < 8; e++) { float v = sO[c * 129 + (i4 * 4 + part) * 8 + e]; ssq += v * v; }
    ssq += __shfl_xor(ssq, 1); ssq += __shfl_xor(ssq, 2);
    float rinv = rsqrtf(ssq * (1.f / 128.f) + EPS);
#pragma unroll
    for (int i4 = 0; i4 < 4; i4++) {
      int dv0 = (i4 * 4 + part) * 8;
      uint4 z = *(const uint4*)(H0 + tk * H0LD + 2816 + hh * 128 + dv0);
      const float* ng = p.e_gla_norm + dv0; const float* so = sO + c * 129 + dv0;
      uint4 ov;
      ov.x = pack2(so[0] * rinv * ng[0] * silu(bflo(z.x)), so[1] * rinv * ng[1] * silu(bfhi(z.x)));
      ov.y = pack2(so[2] * rinv * ng[2] * silu(bflo(z.y)), so[3] * rinv * ng[3] * silu(bfhi(z.y)));
      ov.z = pack2(so[4] * rinv * ng[4] * silu(bflo(z.z)), so[5] * rinv * ng[5] * silu(bfhi(z.z)));
      ov.w = pack2(so[6] * rinv * ng[6] * silu(bflo(z.w)), so[7] * rinv * ng[7] * silu(bfhi(z.w)));
      *(uint4*)(CAT + tk * 1024 + 512 + hh * 128 + dv0) = ov;
    }
  }
  __syncthreads();
}

constexpr int OP_TILES = 256 * 8;
DI void outproj_tile(const Params& p, char* smem, int tm, int tn, int layer) {
  char* ws = p.ws;
  const int tid = threadIdx.x, lane = tid & 63, w = __builtin_amdgcn_readfirstlane(tid >> 6), wp = w >> 1, wq = w & 1, r = lane & 31, h = lane >> 5;
  const int t0 = tm * 128, n0 = tn * 128;
  SrcRM sc{(const bf16_t*)(ws + OFF_REGD), 1024}, sw{(const bf16_t*)(ws + (layer ? OFF_WT_OUT1 : OFF_WT_OUT0)), 1024};
  const float* xres = layer ? p.out : p.x;
  float* Y = (float*)(ws + OFF_REGB);
  f32x16 acc[2][2];
  gemm_tile<2, 2>(smem, sw, n0, sc, t0, 1024, acc);
  epi_store_f32_resid(smem, acc, Y + (size_t)t0 * 1024 + n0, xres + (size_t)t0 * 1024 + n0, 1024);
}
constexpr int LN_TASKS = T / 64;
DI void ln_task(const Params& p, int idx, int layer) {
  char* ws = p.ws;
  const int tid = threadIdx.x, lane = tid & 63, w = __builtin_amdgcn_readfirstlane(tid >> 6);
  const float* Y = (const float*)(ws + OFF_REGB);
  const float* lg = layer ? p.o_ln_g : p.e_ln_g; const float* lb = layer ? p.o_ln_b : p.e_ln_b;
  bf16_t* X1B = (bf16_t*)(ws + OFF_REGF);
  float4 gv[4], bv[4];
#pragma unroll
  for (int q = 0; q < 4; q++) { gv[q] = *(const float4*)(lg + q * 256 + lane * 4); bv[q] = *(const float4*)(lb + q * 256 + lane * 4); }
#pragma unroll 4
  for (int rr = 0; rr < 16; rr++) {
    size_t tok = (size_t)idx * 64 + w * 16 + rr;
    float4 v[4];
    float sum = 0.f;
#pragma unroll
    for (int q = 0; q < 4; q++) { v[q] = *(const float4*)(Y + tok * 1024 + q * 256 + lane * 4); sum += v[q].x + v[q].y + v[q].z + v[q].w; }
#pragma unroll
    for (int o = 32; o >= 1; o >>= 1) sum += __shfl_xor(sum, o);
    float mean = sum * (1.f / 1024.f);
    float sq = 0.f;
#pragma unroll
    for (int q = 0; q < 4; q++) sq += v[q].x * v[q].x + v[q].y * v[q].y + v[q].z * v[q].z + v[q].w * v[q].w;
#pragma unroll
    for (int o = 32; o >= 1; o >>= 1) sq += __shfl_xor(sq, o);
    sq = fmaxf(sq - 1024.f * mean * mean, 0.f);
#pragma unroll
    for (int q = 0; q < 4; q++) { v[q].x -= mean; v[q].y -= mean; v[q].z -= mean; v[q].w -= mean; }
    float rstd = rsqrtf(sq * (1.f / 1024.f) + EPS);
#pragma unroll
    for (int q = 0; q < 4; q++) {
      int n = q * 256 + lane * 4;
      float4 ov;
      ov.x = v[q].x * rstd * gv[q].x + bv[q].x; ov.y = v[q].y * rstd * gv[q].y + bv[q].y; ov.z = v[q].z * rstd * gv[q].z + bv[q].z; ov.w = v[q].w * rstd * gv[q].w + bv[q].w;
      *(float4*)(p.out + tok * 1024 + n) = ov;
      if (!layer) *(uint2*)(X1B + tok * 1024 + n) = pack4(ov.x, ov.y, ov.z, ov.w);
    }
  }
}

constexpr int P5_TOTAL = 256 * 14;
DI void p5_tile(const Params& p, char* smem, int tm, int tn) {
  char* ws = p.ws;
  const int tid = threadIdx.x, lane = tid & 63, w = __builtin_amdgcn_readfirstlane(tid >> 6), wp = w >> 1, wq = w & 1, r = lane & 31, h = lane >> 5;
  SrcRM sx{(const bf16_t*)(ws + OFF_REGF), 1024}, sw{(const bf16_t*)(ws + OFF_WT_IN1), 1024};
  bf16_t* H1 = (bf16_t*)(ws + OFF_H1);
  f32x16 acc[2][2];
  const int t0 = tm * 128, n0 = tn * 128;
  gemm_tile<2, 2>(smem, sw, n0, sx, t0, 1024, acc);
  if (tn == 13 && wp == 0) {
    bf16_t* KR = (bf16_t*)(ws + OFF_KR);
#pragma unroll
    for (int iq = 0; iq < 2; iq++) {
      const size_t tok = (size_t)t0 + (wq * 2 + iq) * 32 + r;
      const float pos = (float)(int)(tok & 2047);
#pragma unroll
      for (int i = 0; i < 8; i++) {
        const int d = crow(i, h);
        float freq = expf(-9.210340371976184f * ((float)d * (1.f / 16.f)));
        float ang = pos * freq; float sn = __sinf(ang), cs = __cosf(ang);
        float x1 = __uint_as_float(f2bf(acc[0][iq][i]) << 16), x2 = __uint_as_float(f2bf(acc[0][iq][i + 8]) << 16);
        KR[tok * 32 + d] = (bf16_t)f2bf(x1 * cs - x2 * sn);
        KR[tok * 32 + 16 + d] = (bf16_t)f2bf(x2 * cs + x1 * sn);
      }
    }
  }
  epi_store_bf16_ssq(smem, acc, H1 + (size_t)t0 * H1LD + n0, H1LD, H1LD - n0, tn < 5 ? (float*)(ws + OFF_SSQ) + (size_t)tn * T + t0 : nullptr);
}

constexpr int P6_Q = 256 * 12, P6_TOTAL = P6_Q + 256 * 16;
DI void p6_task(const Params& p, char* smem, const bool isq, int tm, int tn) {
  char* ws = p.ws;
  const int tid = threadIdx.x, lane = tid & 63, w = __builtin_amdgcn_readfirstlane(tid >> 6), wp = w >> 1, wq = w & 1, r = lane & 31, h = lane >> 5;
  const bf16_t* H1 = (const bf16_t*)(ws + OFF_H1);
  const int t0 = tm * 128, n0 = tn * 128;
  const int KD = isq ? 384 : 256, coff = isq ? 0 : 384;
  float* sRinv = (float*)(smem + 73728);
  if (tid < 128) {
    const float* sq = (const float*)(ws + OFF_SSQ) + (size_t)(t0 + tid);
    sRinv[tid] = isq ? rsqrtf((sq[0] + sq[T] + sq[2 * (size_t)T]) * (1.f / 384.f) + EPS) : rsqrtf((sq[3 * (size_t)T] + sq[4 * (size_t)T]) * (1.f / 256.f) + EPS);
  }
  __syncthreads();
  SrcRM sa{H1 + coff, H1LD};
  f32x16 acc[2][2];
  {
    SrcRM sw{(const bf16_t*)(ws + (isq ? OFF_WT_UQ : OFF_WT_UKV)), KD};
    const bool trv = !isq && tn >= 8;
    gemm_tile<2, 2>(smem, trv ? sa : sw, trv ? t0 : n0, trv ? sw : sa, trv ? n0 : t0, KD, acc);
  }
  if (isq || tn < 8) {
    const float qs = isq ? 0.10206207261596575f : 1.f;
#pragma unroll
    for (int iq = 0; iq < 2; iq++) {
      float sc = sRinv[(wq * 2 + iq) * 32 + r] * qs;
#pragma unroll
      for (int ip = 0; ip < 2; ip++)
#pragma unroll
        for (int i = 0; i < 16; i++) acc[ip][iq][i] *= sc;
    }
    if (isq) epi_store_bf16(smem, acc, (bf16_t*)(ws + OFF_Q1) + (size_t)t0 * 1536 + n0, 1536, 128);
    else epi_store_bf16(smem, acc, (bf16_t*)(ws + OFF_K1) + (size_t)t0 * 1024 + n0, 1024, 128);
  } else {
#pragma unroll
    for (int ip = 0; ip < 2; ip++)
#pragma unroll
      for (int i = 0; i < 16; i++) {
        float sc = sRinv[(wp * 2 + ip) * 32 + crow(i, h)];
#pragma unroll
        for (int iq = 0; iq < 2; iq++) acc[ip][iq][i] *= sc;
      }
    const int b = t0 >> 11, s0 = t0 & 2047;
    epi_store_bf16(smem, acc, (bf16_t*)(ws + OFF_REGF) + ((size_t)(b * 1024 + (n0 - 1024))) * 2048 + s0, 2048, 128);
  }
}

constexpr int P7_TOTAL = 16 * 16 * 16;
DI void mla_task(const Params& p, char* smem, int idx) {
  char* ws = p.ws;
  const int qblk = 15 - (idx >> 8), hd = idx & 15, b = (idx >> 4) & 15;
  int tid_ = threadIdx.x; asm volatile("" : "+v"(tid_));
  const int tid = tid_, lane = tid & 63, w = __builtin_amdgcn_readfirstlane(tid >> 6), r = lane & 31, h = lane >> 5;
  const int t = qblk * 128 + w * 32 + r;
  const size_t tok = (size_t)b * 2048 + t;
  const bf16_t* Q1 = (const bf16_t*)(ws + OFF_Q1);
  const bf16_t* H1 = (const bf16_t*)(ws + OFF_H1);
  bf16x8 qf[6];
#pragma unroll
  for (int s = 0; s < 6; s++) qf[s] = *(const bf16x8*)(Q1 + tok * 1536 + hd * 96 + 16 * s + 8 * h);
  {
    union { bf16x8 v; unsigned short e[8]; } a, c;
    a.v = qf[4]; c.v = qf[5];
#pragma unroll
    for (int j = 0; j < 8; j++) {
      float freq = expf(-9.210340371976184f * ((float)(8 * h + j) * (1.f / 16.f)));
      float ang = (float)t * freq; float sn = __sinf(ang), cs = __cosf(ang);
      float x1 = bf2f(a.e[j]), x2 = bf2f(c.e[j]);
      a.e[j] = (unsigned short)f2bf(x1 * cs - x2 * sn);
      c.e[j] = (unsigned short)f2bf(x2 * cs + x1 * sn);
    }
    qf[4] = a.v; qf[5] = c.v;
  }
  f32x16 o[2];
#pragma unroll
  for (int dt = 0; dt < 2; dt++)
#pragma unroll
    for (int i = 0; i < 16; i++) o[dt][i] = 0.f;
  float m = -INFINITY, l = 0.f;
  const bf16_t* Kb = (const bf16_t*)(ws + OFF_K1) + (size_t)b * 2048 * 1024 + hd * 64;
  const bf16_t* KRb = (const bf16_t*)(ws + OFF_KR) + (size_t)b * 2048 * 32;
  const bf16_t* Vb = (const bf16_t*)(ws + OFF_REGF) + ((size_t)(b * 1024 + hd * 64)) * 2048;
  const int jhi = (qblk * 128 + 127) >> 6, wjhi = (qblk * 128 + w * 32 + 31) >> 6;
  const int tmin = qblk * 128 + w * 32;
  attn_loop<96, false>(tid, smem, qf, 0, jhi, 0xffffffffu, wjhi,
                [&](int key, int kc) { return kc < 8 ? Kb + (size_t)key * 1024 + kc * 8 : KRb + (size_t)key * 32 + (kc - 8) * 8; },
                [&](int row, int key) { return Vb + (size_t)row * 2048 + key; },
                LOG2E, 0.f, t,
                [&](int jt) { return jt * 64 + 63 > tmin; },
                [&](int key, int jt) { return key <= t; },
                o, m, l);
  l += __shfl_xor(l, 32);
  float inv = l > 0.f ? 1.f / l : 0.f;
  bf16_t* CAT = (bf16_t*)(ws + OFF_REGD);
#pragma unroll
  for (int dt = 0; dt < 2; dt++)
#pragma unroll
    for (int gg = 0; gg < 4; gg++) {
      int dv = 32 * dt + 8 * gg + 4 * h;
      uint2 z = *(const uint2*)(H1 + tok * H1LD + 640 + hd * 64 + dv);
      *(uint2*)(CAT + tok * 1024 + hd * 64 + dv) =
          pack4(o[dt][4 * gg] * inv * silu(bflo(z.x)), o[dt][4 * gg + 1] * inv * silu(bfhi(z.x)), o[dt][4 * gg + 2] * inv * silu(bflo(z.y)), o[dt][4 * gg + 3] * inv * silu(bfhi(z.y)));
    }
}


#define XB_TMO      128
#define XB_XCNT(j)  (256  + 64 * (j))
#define XB_XSUB(j)  (1280 + 64 * (j))
#define XB_XGEN(j)  (2304 + 64 * (j))
#define XB_TOP      3328
#define XB_TOPGEN   3392
#define XCD_BAR_WORDS 3456
#define XB_SPIN_CAP (1u << 18)
#define LAS __attribute__((address_space(3)))
DI unsigned xb_ld(unsigned* p) { return __hip_atomic_load(p, __ATOMIC_RELAXED, __HIP_MEMORY_SCOPE_AGENT); }
DI unsigned xb_add(unsigned* p, unsigned v) { return __hip_atomic_fetch_add(p, v, __ATOMIC_RELAXED, __HIP_MEMORY_SCOPE_AGENT); }
DI unsigned xb_xcc_id() { return (unsigned)__builtin_amdgcn_s_getreg((3 << 11) | 20) & 0xFu; }
#define XB_SPIN(cond, bar) do { unsigned _sp = 0; while (cond) { __builtin_amdgcn_s_sleep(1); \
    if ((++_sp & 255u) == 0u) { if (xb_ld(&(bar)[XB_TMO])) break; if (_sp > XB_SPIN_CAP) { atomicAdd(&(bar)[XB_TMO], 1u); break; } } } } while (0)
struct XcdBarrier { unsigned* bar; unsigned x; volatile LAS unsigned* st; };
DI XcdBarrier xcd_barrier_post(unsigned* bar, volatile LAS unsigned* st) {
  XcdBarrier b; b.bar = bar; b.x = xb_xcc_id(); b.st = st;
  if (threadIdx.x == 0) (void)xb_add(&bar[XB_XCNT(b.x)], 1u);
  return b;
}
DI void xcd_barrier_complete(unsigned* bar, unsigned x, unsigned& nloc, unsigned& nx) {
  const unsigned G = gridDim.x * gridDim.y * gridDim.z;
  unsigned sum, cnt, mine, sp = 0u;
  for (;;) {
    sum = 0u; cnt = 0u; mine = 0u;
#pragma unroll
    for (unsigned j = 0; j < 16; ++j) { const unsigned c = xb_ld(&bar[XB_XCNT(j)]); sum += c; cnt += (c > 0u) ? 1u : 0u; mine = (j == x) ? c : mine; }
    if (sum == G) break;
    __builtin_amdgcn_s_sleep(1);
    if ((++sp & 255u) == 0u) { if (xb_ld(&bar[XB_TMO])) break; if (sp > XB_SPIN_CAP) { atomicAdd(&bar[XB_TMO], 1u); break; } }
  }
  nloc = mine > 0u ? mine : 1u; nx = cnt > 0u ? cnt : 1u;
}
DI void xcd_barrier(const XcdBarrier& b) {
  asm volatile("s_waitcnt vmcnt(0)" ::: "memory");
  __syncthreads();
  if (threadIdx.x == 0) {
    unsigned* bar = b.bar;
    __builtin_amdgcn_s_waitcnt(0);
    unsigned nloc = b.st[0], nx = b.st[1];
    if (nloc == 0u) { xcd_barrier_complete(bar, b.x, nloc, nx); b.st[0] = nloc; b.st[1] = nx; }
    const unsigned old = xb_add(&bar[XB_XSUB(b.x)], 1u);
    const unsigned gen = old / nloc;
    if (old + 1u == (gen + 1u) * nloc) {
      __builtin_amdgcn_fence(__ATOMIC_RELEASE, "agent");
      asm volatile("s_waitcnt vmcnt(0)" ::: "memory");
      const unsigned og = xb_add(&bar[XB_TOP], 1u);
      const unsigned tg = og / nx;
      if (og + 1u == (tg + 1u) * nx) xb_add(&bar[XB_TOPGEN], 1u);
      else XB_SPIN(xb_ld(&bar[XB_TOPGEN]) == tg, bar);
      __builtin_amdgcn_fence(__ATOMIC_ACQUIRE, "agent");
      xb_add(&bar[XB_XGEN(b.x)], 1u);
      asm volatile("s_waitcnt vmcnt(0)" ::: "memory");
    } else {
      XB_SPIN(xb_ld(&bar[XB_XGEN(b.x)]) == gen, bar);
      __builtin_amdgcn_fence(__ATOMIC_ACQUIRE, "agent");
      asm volatile("s_waitcnt vmcnt(0)" ::: "memory");
    }
  }
  __syncthreads();
}

__global__ void __launch_bounds__(256, 2) nsa_gla_mla_mega(Params p) {
  __shared__ __attribute__((aligned(16))) char smem[SMEM_BYTES];
  __shared__ int s_task;
  __shared__ uint4 xb_words;
  cg::grid_group grid = cg::this_grid();
  if (threadIdx.x == 0) xb_words = make_uint4(0u, 0u, 0u, 0u);
  __syncthreads();
  XcdBarrier xb = xcd_barrier_post((unsigned*)(p.ws + OFF_CTR), (volatile LAS unsigned*)&xb_words);
  if (p.phase_end == 12345) grid.sync();
  int* ctr = (int*)(p.ws + OFF_CTR + 14336);
#ifndef SKIPMASK
#define SKIPMASK 0
#endif
#define PHASE_ON(n) (!((SKIPMASK >> (n)) & 1) && p.phase_begin <= (n) && (n) < p.phase_end)
#define PHASE_SYNC(n) if (p.phase_begin <= (n) && (n) + 1 < p.phase_end) xcd_barrier(xb);
#ifndef DUPMASK
#define DUPMASK 0
#endif
#define NREP(n) (1 + ((DUPMASK >> (n)) & 1))
#define XCD_TILE_LOOP(RT, CT, RS, CS, CALL) { const int x_ = blockIdx.x & 7, rs_ = x_ / (CS), cs_ = x_ % (CS); const int nr_ = (RT) / (RS), r0_ = rs_ * nr_; \
    const int c0_ = (cs_ * (CT)) / (CS), nc_ = ((cs_ + 1) * (CT)) / (CS) - c0_; \
    for (int j_ = blockIdx.x >> 3; j_ < nr_ * nc_; j_ += gridDim.x >> 3) { const int tm = r0_ + j_ / nc_, tn = c0_ + j_ % nc_; CALL; } }
#define QUEUE_LOOP(CTR, NTASK, CALL) for (;;) { if (threadIdx.x == 0) s_task = atomicAdd(&ctr[CTR], 1); __syncthreads(); int tk = s_task; __syncthreads(); if (tk >= (NTASK)) break; CALL; __syncthreads(); }
  if (PHASE_ON(0)) for (int rep = 0; rep < NREP(0); rep++) for (int i = blockIdx.x; i < P0_TOTAL; i += gridDim.x) p0_task(p, smem, i);
  PHASE_SYNC(0)
  if (PHASE_ON(1)) for (int rep = 0; rep < NREP(1); rep++) XCD_TILE_LOOP(256, 27, 2, 4, p1_tile(p, smem, tm, tn))
  PHASE_SYNC(1)
  if (PHASE_ON(2)) for (int rep = 0; rep < NREP(2); rep++) {
    QUEUE_LOOP(3 + 8 * rep, P2_TOTAL, p2_task(p, smem, tk))
    QUEUE_LOOP(4 + 8 * rep, GLA_CHUNK_TASKS, gla_a_task(p, smem, tk))
  }
  PHASE_SYNC(2)
  if (PHASE_ON(3)) for (int rep = 0; rep < NREP(3); rep++) {
    QUEUE_LOOP(0 + 8 * rep, GLA_B_TASKS, gla_b_task(p, tk))
    QUEUE_LOOP(2 + 8 * rep, NSA_TASKS, nsa_task(p, smem, tk))
  }
  PHASE_SYNC(3)
  if (PHASE_ON(4)) for (int rep = 0; rep < NREP(4); rep++) for (int i = blockIdx.x; i < GLA_CHUNK_TASKS; i += gridDim.x) gla_c_task(p, smem, i);
  PHASE_SYNC(4)
  if (PHASE_ON(5)) for (int rep = 0; rep < NREP(5); rep++) XCD_TILE_LOOP(256, 8, 8, 1, outproj_tile(p, smem, tm, tn, 0))
  PHASE_SYNC(5)
  if (PHASE_ON(6)) for (int rep = 0; rep < NREP(6); rep++) for (int i = blockIdx.x; i < LN_TASKS; i += gridDim.x) ln_task(p, i, 0);
  PHASE_SYNC(6)
  if (PHASE_ON(7)) for (int rep = 0; rep < NREP(7); rep++) XCD_TILE_LOOP(256, 14, 4, 2, p5_tile(p, smem, tm, tn))
  PHASE_SYNC(7)
  if (PHASE_ON(9)) for (int rep = 0; rep < NREP(9); rep++) { XCD_TILE_LOOP(256, 16, 8, 1, p6_task(p, smem, false, tm, tn)) XCD_TILE_LOOP(256, 12, 8, 1, p6_task(p, smem, true, tm, tn)) }
  PHASE_SYNC(9)
  if (PHASE_ON(10)) for (int rep = 0; rep < NREP(10); rep++) {
    QUEUE_LOOP(1 + 8 * rep, P7_TOTAL, mla_task(p, smem, tk))
  }
  PHASE_SYNC(10)
  if (PHASE_ON(11)) XCD_TILE_LOOP(256, 8, 8, 1, outproj_tile(p, smem, tm, tn, 1))
  PHASE_SYNC(11)
  if (PHASE_ON(12)) for (int i = blockIdx.x; i < LN_TASKS; i += gridDim.x) ln_task(p, i, 1);
}

#ifndef N_LAUNCH_SPLIT
#define N_LAUNCH_SPLIT 0
#endif

extern "C" void kernel_launch(void* const* d_in, const int* in_sizes, int n_in, void* d_out, int out_size, void* d_ws, size_t ws_size,
                              hipStream_t stream) {
  static int grid_blocks = 0;
  if (!grid_blocks) {
    int dev = 0, cus = 0, per_cu = 0;
    hipGetDevice(&dev);
    hipDeviceGetAttribute(&cus, hipDeviceAttributeMultiprocessorCount, dev);
    hipOccupancyMaxActiveBlocksPerMultiprocessor(&per_cu, nsa_gla_mla_mega, 256, 0);
    if (per_cu < 1) per_cu = 1;
    if (per_cu > 2) per_cu = 2;
    grid_blocks = cus * per_cu;
  }
  Params p{};
  const float** f = (const float**)&p;
  for (int i = 0; i < 19; i++) f[i] = (const float*)d_in[i];
  p.out = (float*)d_out;
  p.ws = (char*)d_ws;
  (void)hipMemsetAsync((char*)d_ws + OFF_CTR, 0, 16384, stream);
#if N_LAUNCH_SPLIT
  for (int ph = 0; ph < 13; ph++) {
    p.phase_begin = ph; p.phase_end = ph + 1;
    hipLaunchKernelGGL(nsa_gla_mla_mega, dim3(grid_blocks), dim3(256), 0, stream, p);
  }
#else
  p.phase_begin = 0; p.phase_end = 13;
  void* args[] = {&p};
  hipError_t e = hipLaunchCooperativeKernel((void*)nsa_gla_mla_mega, dim3(grid_blocks), dim3(256), args, 0, stream);
  if (e != hipSuccess) fprintf(stderr, "cooperative launch failed: %s (grid %d)\n", hipGetErrorString(e), grid_blocks);
#endif
}
```

```cpp
#include <hip/hip_runtime.h>
#include <hip/hip_cooperative_groups.h>
#include <cstdio>
namespace cg = cooperative_groups;

#define DI __device__ __forceinline__
typedef unsigned short bf16_t;
typedef __attribute__((ext_vector_type(8))) short bf16x8;
typedef __attribute__((ext_vector_type(4))) short s16x4;
typedef __attribute__((ext_vector_type(16))) float f32x16;
typedef __attribute__((ext_vector_type(4))) unsigned u32x4;
#define MFMA32(a, b, c) __builtin_amdgcn_mfma_f32_32x32x16_bf16((a), (b), (c), 0, 0, 0)

constexpr int S = 2048, T = 16 * 2048;
constexpr int H0LD = 3392, H0N = 3456, H1LD = 1696, H1N = 1792;
constexpr int LDS_ROW = 144;
constexpr float LOG2E = 1.4426950408889634f;
constexpr float ALPHA = 1.4142135623730951f;
constexpr float EPS = 1e-5f;

constexpr size_t al256(size_t x) { return (x + 255) & ~size_t(255); }
constexpr size_t OFF_CTR = 0;
constexpr size_t OFF_WT_IN0 = 16384;
constexpr size_t OFF_WT_OUT0 = OFF_WT_IN0 + (size_t)H0N * 1024 * 2;
constexpr size_t OFF_WT_IN1 = OFF_WT_OUT0 + (size_t)1024 * 1024 * 2;
constexpr size_t OFF_WT_UQ = OFF_WT_IN1 + (size_t)H1N * 1024 * 2;
constexpr size_t OFF_WT_UKV = OFF_WT_UQ + (size_t)1536 * 384 * 2;
constexpr size_t OFF_WT_OUT1 = OFF_WT_UKV + (size_t)2048 * 256 * 2;
constexpr size_t OFF_W1T = OFF_WT_OUT1 + (size_t)1024 * 1024 * 2;
constexpr size_t OFF_W2T = OFF_W1T + (size_t)2 * 128 * 2048 * 2;
constexpr size_t OFF_BIAS1 = OFF_W2T + (size_t)2 * 64 * 128 * 2;
constexpr size_t OFF_REGB = al256(OFF_BIAS1 + 2 * 128 * 4);
constexpr size_t REGB_SZ = (size_t)T * H0LD * 2;
constexpr size_t OFF_H1 = OFF_REGB;
constexpr size_t OFF_Q1 = OFF_REGB + al256((size_t)T * H1LD * 2);
constexpr size_t OFF_REGC = OFF_REGB + REGB_SZ;
constexpr size_t OFF_VTNSA = OFF_REGC;
constexpr size_t OFF_VTGLA = OFF_VTNSA + (size_t)16 * 256 * 2048 * 2;
constexpr size_t OFF_KCMP = OFF_VTGLA + (size_t)16 * 512 * 2048 * 2;
constexpr size_t OFF_VCMPT = OFF_KCMP + (size_t)16 * 2 * 128 * 64 * 2;
constexpr size_t OFF_K1 = OFF_REGC;
constexpr size_t OFF_REGD = OFF_REGC + (size_t)T * 1024 * 2;
constexpr size_t OFF_REGF = OFF_REGD + (size_t)T * 1024 * 2;
constexpr size_t OFF_KR = OFF_REGF + (size_t)T * 1024 * 2;
constexpr size_t OFF_RINV = OFF_KR + (size_t)T * 32 * 2;
constexpr size_t OFF_QD = OFF_RINV + (size_t)T * 2 * 4;
constexpr size_t OFF_OI = OFF_QD + (size_t)T * 256 * 2;
constexpr size_t OFF_ST = OFF_OI + (size_t)T * 512 * 2;
constexpr size_t OFF_DEC = OFF_ST + (size_t)2048 * 128 * 64 * 2;
constexpr size_t OFF_UPD = OFF_REGF;
constexpr size_t OFF_SSQ = OFF_DEC + (size_t)2048 * 64 * 4;
constexpr size_t WS_TOTAL = OFF_SSQ + (size_t)T * 8 * 4;
static_assert(WS_TOTAL <= (size_t)536870912, "ws budget");
static_assert(OFF_Q1 + (size_t)T * 1536 * 2 <= OFF_REGC, "regB");
static_assert(OFF_VCMPT + (size_t)16 * 2 * 64 * 128 * 2 <= OFF_REGD, "regC");

constexpr int SMEM_BYTES = 73728 + 1024 + 64;

struct Params {
  const float *x, *e_w_in, *e_cmp_pe, *e_cmp_w1, *e_cmp_w2, *e_gla_w_gate, *e_gla_b_gate, *e_gla_norm, *e_w_out, *e_ln_g, *e_ln_b;
  const float *o_w_in, *o_q_norm, *o_w_uq, *o_kv_norm, *o_w_ukv, *o_w_out, *o_ln_g, *o_ln_b;
  float* out;
  char* ws;
  int phase_begin, phase_end;
};

typedef __bf16 bf2_t __attribute__((ext_vector_type(2)));
typedef float f2_t __attribute__((ext_vector_type(2)));
DI unsigned pack2(float a, float b) { f2_t v = {a, b}; bf2_t r = __builtin_convertvector(v, bf2_t); return __builtin_bit_cast(unsigned, r); }
DI unsigned f2bf(float x) { return pack2(x, 0.f) & 0xffffu; }
DI float bflo(unsigned u) { return __uint_as_float(u << 16); }
DI float bfhi(unsigned u) { return __uint_as_float(u & 0xffff0000u); }
DI float bf2f(bf16_t s) { return __uint_as_float(((unsigned)s) << 16); }
DI int crow(int i, int h) { return (i & 3) + 8 * (i >> 2) + 4 * h; }
DI uint2 pack4(float a, float b, float c, float d) { uint2 r; r.x = pack2(a, b); r.y = pack2(c, d); return r; }
DI float fexp2(float x) { return __builtin_amdgcn_exp2f(x); }
DI float silu(float v) { return v / (1.f + __expf(-v)); }
DI bf16x8 pack8(const f32x16& x, int s8) {
  union { uint4 u; bf16x8 v; } r;
  r.u.x = pack2(x[s8 + 0], x[s8 + 1]); r.u.y = pack2(x[s8 + 2], x[s8 + 3]);
  r.u.z = pack2(x[s8 + 4], x[s8 + 5]); r.u.w = pack2(x[s8 + 6], x[s8 + 7]);
  return r.v;
}
DI bf16x8 ld2x8(const char* p) {
  union { uint4 u; bf16x8 v; } r;
  uint2 a = *(const uint2*)p, b = *(const uint2*)(p + 16);
  r.u.x = a.x; r.u.y = a.y; r.u.z = b.x; r.u.w = b.y;
  return r.v;
}

struct SrcRM { const bf16_t* base; int ld; DI const bf16_t* ptr(int row, int k0, int kc) const { return base + (size_t)row * ld + k0 + kc * 8; } };
struct SrcCmp { const bf16_t* base; DI const bf16_t* ptr(int row, int k0, int kc) const { int n = row > 126 ? 126 : row; return base + (size_t)(16 * n + (k0 >> 6)) * H0LD + kc * 8; } };

template <int PT, int QT, class SP, class SQ>
DI void gemm_tile(char* smem, const SP& sp, int prow0, const SQ& sq, int qrow0, int K, f32x16 (&acc)[PT][QT]) {
  constexpr int PB = 64 * PT * LDS_ROW, STG = 64 * (PT + QT) * LDS_ROW;
  const int tid = threadIdx.x, lane = tid & 63, w = __builtin_amdgcn_readfirstlane(tid >> 6), wp = w >> 1, wq = w & 1, r = lane & 31, h = lane >> 5;
  u32x4 rpA[2 * PT], rqA[2 * QT];
#pragma unroll
  for (int ip = 0; ip < PT; ip++)
#pragma unroll
    for (int iq = 0; iq < QT; iq++)
#pragma unroll
      for (int i = 0; i < 16; i++) acc[ip][iq][i] = 0.f;
#define GT_GLOAD(RP, RQ, K0) { _Pragma("unroll") for (int i = 0; i < 2 * PT; i++) { int c = tid + 256 * i; RP[i] = *(const u32x4*)sp.ptr(prow0 + (c >> 3), (K0), c & 7); } \
    _Pragma("unroll") for (int i = 0; i < 2 * QT; i++) { int c = tid + 256 * i; RQ[i] = *(const u32x4*)sq.ptr(qrow0 + (c >> 3), (K0), c & 7); } }
#define GT_SSTORE(RP, RQ, ST) { char* st_ = (ST); _Pragma("unroll") for (int i = 0; i < 2 * PT; i++) { int c = tid + 256 * i; *(u32x4*)(st_ + (c >> 3) * LDS_ROW + (c & 7) * 16) = RP[i]; } \
    _Pragma("unroll") for (int i = 0; i < 2 * QT; i++) { int c = tid + 256 * i; *(u32x4*)(st_ + PB + (c >> 3) * LDS_ROW + (c & 7) * 16) = RQ[i]; } }
#define GT_COMPUTE(ST) { const char* sP = (ST); const char* sQ = sP + PB; __builtin_amdgcn_iglp_opt(0); \
    _Pragma("unroll") for (int s = 0; s < 4; s++) { bf16x8 a[PT], b[QT]; \
      _Pragma("unroll") for (int ip = 0; ip < PT; ip++) a[ip] = *(const bf16x8*)(sP + ((wp * PT + ip) * 32 + r) * LDS_ROW + s * 32 + h * 16); \
      _Pragma("unroll") for (int iq = 0; iq < QT; iq++) b[iq] = *(const bf16x8*)(sQ + ((wq * QT + iq) * 32 + r) * LDS_ROW + s * 32 + h * 16); \
      _Pragma("unroll") for (int ip = 0; ip < PT; ip++) _Pragma("unroll") for (int iq = 0; iq < QT; iq++) acc[ip][iq] = MFMA32(a[ip], b[iq], acc[ip][iq]); } }
  const int nk = K >> 6;
  GT_GLOAD(rpA, rqA, 0);
  GT_SSTORE(rpA, rqA, smem);
  if (nk > 1) GT_GLOAD(rpA, rqA, 64);
  for (int kt = 0; kt < nk; kt++) {
    __syncthreads();
    if (kt + 1 < nk) {
      GT_SSTORE(rpA, rqA, smem + ((kt + 1) & 1) * STG);
      if (kt + 2 < nk) GT_GLOAD(rpA, rqA, (kt + 2) * 64);
    }
    __builtin_amdgcn_sched_barrier(0);
    GT_COMPUTE(smem + (kt & 1) * STG);
  }
  __syncthreads();
#undef GT_GLOAD
#undef GT_SSTORE
#undef GT_COMPUTE
}

DI void epi_store_bf16(char* smem, const f32x16 (&acc)[2][2], bf16_t* dst, size_t ld, int valid) {
  const int tid = threadIdx.x, lane = tid & 63, w = __builtin_amdgcn_readfirstlane(tid >> 6), wp = w >> 1, wq = w & 1, r = lane & 31, h = lane >> 5;
#pragma unroll
  for (int ip = 0; ip < 2; ip++)
#pragma unroll
    for (int iq = 0; iq < 2; iq++)
#pragma unroll
      for (int gg = 0; gg < 4; gg++)
        *(uint2*)(smem + ((wq * 2 + iq) * 32 + r) * 272 + ((wp * 2 + ip) * 32 + 8 * gg + 4 * h) * 2) = pack4(acc[ip][iq][4 * gg], acc[ip][iq][4 * gg + 1], acc[ip][iq][4 * gg + 2], acc[ip][iq][4 * gg + 3]);
  __syncthreads();
#pragma unroll
  for (int i = 0; i < 8; i++) {
    int c = tid + 256 * i; int row = c >> 4, ch = c & 15;
    if (ch * 8 < valid) *(uint4*)(dst + (size_t)row * ld + ch * 8) = *(const uint4*)(smem + row * 272 + ch * 16);
  }
  __syncthreads();
}
DI void epi_store_bf16_ssq(char* smem, const f32x16 (&acc)[2][2], bf16_t* dst, size_t ld, int valid, float* ssq) {
  int tid_ = threadIdx.x; asm volatile("" : "+v"(tid_));
  const int tid = tid_, lane = tid & 63, w = __builtin_amdgcn_readfirstlane(tid >> 6), wp = w >> 1, wq = w & 1, r = lane & 31, h = lane >> 5;
#pragma unroll
  for (int ip = 0; ip < 2; ip++)
#pragma unroll
    for (int iq = 0; iq < 2; iq++)
#pragma unroll
      for (int gg = 0; gg < 4; gg++)
        *(uint2*)(smem + ((wq * 2 + iq) * 32 + r) * 272 + ((wp * 2 + ip) * 32 + 8 * gg + 4 * h) * 2) = pack4(acc[ip][iq][4 * gg], acc[ip][iq][4 * gg + 1], acc[ip][iq][4 * gg + 2], acc[ip][iq][4 * gg + 3]);
  __syncthreads();
#pragma unroll
  for (int i = 0; i < 8; i++) {
    int c = tid + 256 * i; int row = c >> 4, ch = c & 15;
    uint4 u = *(const uint4*)(smem + row * 272 + ch * 16);
    if (ch * 8 < valid) *(uint4*)(dst + (size_t)row * ld + ch * 8) = u;
    if (ssq) {
      float a0 = bflo(u.x), a1 = bfhi(u.x), a2 = bflo(u.y), a3 = bfhi(u.y), a4 = bflo(u.z), a5 = bfhi(u.z), a6 = bflo(u.w), a7 = bfhi(u.w);
      float s = a0 * a0 + a1 * a1 + a2 * a2 + a3 * a3 + a4 * a4 + a5 * a5 + a6 * a6 + a7 * a7;
      s += __shfl_xor(s, 8); s += __shfl_xor(s, 4); s += __shfl_xor(s, 2); s += __shfl_xor(s, 1);
      if (ch == 0) ssq[row] = s;
    }
  }
  __syncthreads();
}
DI void epi_store_f32_resid(char* smem, const f32x16 (&acc)[2][2], float* dst, const float* xres, size_t ld) {
  const int tid = threadIdx.x, lane = tid & 63, w = __builtin_amdgcn_readfirstlane(tid >> 6), wp = w >> 1, wq = w & 1, r = lane & 31, h = lane >> 5;
#pragma unroll
  for (int ip = 0; ip < 2; ip++)
#pragma unroll
    for (int iq = 0; iq < 2; iq++)
#pragma unroll
      for (int gg = 0; gg < 4; gg++) {
        float4 v; v.x = acc[ip][iq][4 * gg]; v.y = acc[ip][iq][4 * gg + 1]; v.z = acc[ip][iq][4 * gg + 2]; v.w = acc[ip][iq][4 * gg + 3];
        *(float4*)(smem + ((wq * 2 + iq) * 32 + r) * 528 + ((wp * 2 + ip) * 32 + 8 * gg + 4 * h) * 4) = v;
      }
  __syncthreads();
#pragma unroll
  for (int i = 0; i < 16; i++) {
    int c = tid + 256 * i; int row = c >> 5, ch = c & 31;
    float4 y = *(const float4*)(smem + row * 528 + ch * 16);
    float4 xv = *(const float4*)(xres + (size_t)row * ld + ch * 4);
    y.x += ALPHA * xv.x; y.y += ALPHA * xv.y; y.z += ALPHA * xv.z; y.w += ALPHA * xv.w;
    *(float4*)(dst + (size_t)row * ld + ch * 4) = y;
  }
  __syncthreads();
}

DI int map_h0(int n) {
  if (n < 1280) return n;
  if (n < 1792) return 1304 + (n - 1280);
  if (n < 2048) return 1816 + (n - 1792);
  if (n < 2304) return 2072 + (n - 2048);
  if (n < 2816) return 2328 + (n - 2304);
  if (n < 3328) return 2856 + (n - 2816);
  if (n < 3352) return 1280 + (n - 3328);
  if (n < 3360) return -1;
  if (n < 3376) return 2840 + (n - 3360);
  return -1;
}
DI int map_h1(int n) {
  if (n < 640) return n;
  if (n < 1664) return 672 + (n - 640);
  if (n < 1696) return 640 + (n - 1664);
  return -1;
}
DI int map_kv(int n) {
  if (n < 1024) return (n >> 6) * 128 + (n & 63);
  n -= 1024;
  return (n >> 6) * 128 + 64 + (n & 63);
}
DI void prep_tile(char* smem, bf16_t* dst, int K, const float* src, int ld, int mapid, const float* scale, int n0, int k0) {
  float* t = (float*)smem;
  const int tid = threadIdx.x;
  {
    int nl = tid & 63, kg = tid >> 6, n = n0 + nl;
    int sc = mapid == 0 ? n : mapid == 1 ? map_h0(n) : mapid == 2 ? map_h1(n) : map_kv(n);
#pragma unroll 4
    for (int i = 0; i < 16; i++) {
      int k = kg * 16 + i;
      float v = sc >= 0 ? src[(size_t)(k0 + k) * ld + sc] : 0.f;
      if (scale) v *= scale[k0 + k];
      t[k * 65 + nl] = v;
    }
  }
  __syncthreads();
  {
    int n = tid >> 2, kq = (tid & 3) * 16;
    uint4 a, b;
    a.x = pack2(t[(kq + 0) * 65 + n], t[(kq + 1) * 65 + n]); a.y = pack2(t[(kq + 2) * 65 + n], t[(kq + 3) * 65 + n]);
    a.z = pack2(t[(kq + 4) * 65 + n], t[(kq + 5) * 65 + n]); a.w = pack2(t[(kq + 6) * 65 + n], t[(kq + 7) * 65 + n]);
    b.x = pack2(t[(kq + 8) * 65 + n], t[(kq + 9) * 65 + n]); b.y = pack2(t[(kq + 10) * 65 + n], t[(kq + 11) * 65 + n]);
    b.z = pack2(t[(kq + 12) * 65 + n], t[(kq + 13) * 65 + n]); b.w = pack2(t[(kq + 14) * 65 + n], t[(kq + 15) * 65 + n]);
    bf16_t* d = dst + (size_t)(n0 + n) * K + k0 + kq;
    *(uint4*)d = a; *(uint4*)(d + 8) = b;
  }
  __syncthreads();
}
constexpr int P0_J0 = 54 * 16, P0_J1 = P0_J0 + 256, P0_J2 = P0_J1 + 28 * 16, P0_J3 = P0_J2 + 24 * 6, P0_J4 = P0_J3 + 32 * 4,
              P0_J5 = P0_J4 + 256, P0_J6 = P0_J5 + 2 * 2 * 32, P0_J7 = P0_J6 + 2 * 2, P0_J8 = P0_J7 + 16, P0_TOTAL = P0_J8 + 4096;
DI void p0_task(const Params& p, char* smem, int idx) {
  char* ws = p.ws;
  const int tid = threadIdx.x;
  if (idx < P0_J0) { prep_tile(smem, (bf16_t*)(ws + OFF_WT_IN0), 1024, p.e_w_in, 3368, 1, nullptr, (idx >> 4) * 64, (idx & 15) * 64); return; }
  if (idx < P0_J1) { int t = idx - P0_J0; prep_tile(smem, (bf16_t*)(ws + OFF_WT_OUT0), 1024, p.e_w_out, 1024, 0, nullptr, (t >> 4) * 64, (t & 15) * 64); return; }
  if (idx < P0_J2) { int t = idx - P0_J1; prep_tile(smem, (bf16_t*)(ws + OFF_WT_IN1), 1024, p.o_w_in, 1696, 2, nullptr, (t >> 4) * 64, (t & 15) * 64); return; }
  if (idx < P0_J3) { int t = idx - P0_J2; prep_tile(smem, (bf16_t*)(ws + OFF_WT_UQ), 384, p.o_w_uq, 1536, 0, p.o_q_norm, (t / 6) * 64, (t % 6) * 64); return; }
  if (idx < P0_J4) { int t = idx - P0_J3; prep_tile(smem, (bf16_t*)(ws + OFF_WT_UKV), 256, p.o_w_ukv, 2048, 3, p.o_kv_norm, (t >> 2) * 64, (t & 3) * 64); return; }
  if (idx < P0_J5) { int t = idx - P0_J4; prep_tile(smem, (bf16_t*)(ws + OFF_WT_OUT1), 1024, p.o_w_out, 1024, 0, nullptr, (t >> 4) * 64, (t & 15) * 64); return; }
  if (idx < P0_J6) { int t = idx - P0_J5; int j = t >> 6; t &= 63; prep_tile(smem, (bf16_t*)(ws + OFF_W1T) + (size_t)j * 128 * 2048, 2048, p.e_cmp_w1 + (size_t)j * 2048 * 128, 128, 0, nullptr, (t >> 5) * 64, (t & 31) * 64); return; }
  if (idx < P0_J7) { int t = idx - P0_J6; int j = t >> 1; prep_tile(smem, (bf16_t*)(ws + OFF_W2T) + (size_t)j * 64 * 128, 128, p.e_cmp_w2 + (size_t)j * 128 * 64, 64, 0, nullptr, 0, (t & 1) * 64); return; }
  if (idx < P0_J8) {
    int t = idx - P0_J7; int j = t >> 3, mg = t & 7;
    int m = mg * 16 + (tid & 15), ks = tid >> 4;
    const float* pe = p.e_cmp_pe + (size_t)j * 2048; const float* w1 = p.e_cmp_w1 + (size_t)j * 2048 * 128;
    float acc = 0.f;
    for (int kk = ks * 128; kk < ks * 128 + 128; kk++) acc += pe[kk] * w1[(size_t)kk * 128 + m];
    float* red = (float*)smem;
    red[tid] = acc;
    __syncthreads();
    if (tid < 16) { float s = 0.f; for (int q = 0; q < 16; q++) s += red[q * 16 + tid]; ((float*)(ws + OFF_BIAS1))[j * 128 + mg * 16 + tid] = s; }
    __syncthreads();
    return;
  }
  {
    int t = idx - P0_J8;
    float4 a[4], b[4];
#pragma unroll
    for (int q = 0; q < 4; q++) { size_t e = ((size_t)(t * 4 + q) * 256 + tid) * 8; a[q] = *(const float4*)(p.x + e); b[q] = *(const float4*)(p.x + e + 4); }
#pragma unroll
    for (int q = 0; q < 4; q++) {
      size_t e = ((size_t)(t * 4 + q) * 256 + tid) * 8;
      uint4 o; o.x = pack2(a[q].x, a[q].y); o.y = pack2(a[q].z, a[q].w); o.z = pack2(b[q].x, b[q].y); o.w = pack2(b[q].z, b[q].w);
      *(uint4*)((bf16_t*)(ws + OFF_REGD) + e) = o;
    }
  }
}

constexpr int P1_TOTAL = 256 * 27;
DI void p1_tile(const Params& p, char* smem, int tm, int tn) {
  char* ws = p.ws;
  const int tid = threadIdx.x, lane = tid & 63, w = __builtin_amdgcn_readfirstlane(tid >> 6), wp = w >> 1, wq = w & 1, r = lane & 31, h = lane >> 5;
  SrcRM sx{(const bf16_t*)(ws + OFF_REGD), 1024}, sw{(const bf16_t*)(ws + OFF_WT_IN0), 1024};
  bf16_t* H0 = (bf16_t*)(ws + OFF_REGB);
  f32x16 acc[2][2];
  const int t0 = tm * 128, n0 = tn * 128;
  const bool tr = (tn == 7 || tn == 9 || (tn >= 18 && tn < 22));
  gemm_tile<2, 2>(smem, tr ? sx : sw, tr ? t0 : n0, tr ? sw : sx, tr ? n0 : t0, 1024, acc);
  if (!tr) {
    epi_store_bf16(smem, acc, H0 + (size_t)t0 * H0LD + n0, H0LD, H0LD - n0);
  } else {
    bf16_t* dst; int c0, NC;
    if (tn == 7) { dst = (bf16_t*)(ws + OFF_VTNSA); c0 = 0; NC = 256; }
    else if (tn == 9) { dst = (bf16_t*)(ws + OFF_VTNSA); c0 = 128; NC = 256; }
    else { dst = (bf16_t*)(ws + OFF_VTGLA); c0 = (tn - 18) * 128; NC = 512; }
    const int b = t0 >> 11, s0 = t0 & 2047;
    epi_store_bf16(smem, acc, dst + ((size_t)(b * NC + c0)) * 2048 + s0, 2048, 128);
  }
}

constexpr int P2_TOTAL = 128;
DI void p2_task(const Params& p, char* smem, int idx) {
  char* ws = p.ws;
  const int half = idx & 1, j = (idx >> 1) & 1, g = (idx >> 2) & 1, b = idx >> 3;
  const int tid = threadIdx.x, lane = tid & 63, w = __builtin_amdgcn_readfirstlane(tid >> 6), wp = w >> 1, wq = w & 1, r = lane & 31, h = lane >> 5;
  const bf16_t* H0 = (const bf16_t*)(ws + OFF_REGB);
  SrcCmp sa{H0 + (size_t)b * 2048 * H0LD + 512 + j * 128 + g * 64};
  SrcRM sw{(const bf16_t*)(ws + OFF_W1T) + (size_t)j * 128 * 2048, 2048};
  f32x16 acc[1][2];
  gemm_tile<1, 2>(smem, sa, half * 64, sw, 0, 2048, acc);
  const float* bias = (const float*)(ws + OFF_BIAS1) + j * 128;
  char* sH = smem; char* sW = smem + 64 * 272;
#pragma unroll
  for (int iq = 0; iq < 2; iq++) {
    int m = (wq * 2 + iq) * 32 + r; float bm = bias[m];
#pragma unroll
    for (int i = 0; i < 16; i++) {
      int nl = wp * 32 + crow(i, h);
      ((bf16_t*)(sH + nl * 272))[m] = (bf16_t)f2bf(silu(acc[0][iq][i] + bm));
    }
  }
  const bf16_t* W2T = (const bf16_t*)(ws + OFF_W2T) + (size_t)j * 64 * 128;
#pragma unroll
  for (int i = 0; i < 4; i++) { int c = tid + 256 * i; int row = c >> 4, kc = c & 15; *(uint4*)(sW + row * 272 + kc * 16) = *(const uint4*)(W2T + row * 128 + kc * 8); }
  __syncthreads();
  f32x16 o;
#pragma unroll
  for (int i = 0; i < 16; i++) o[i] = 0.f;
  if (j == 0) {
#pragma unroll
    for (int s = 0; s < 8; s++) {
      bf16x8 a = *(const bf16x8*)(sW + (wp * 32 + r) * 272 + s * 32 + h * 16);
      bf16x8 bq = *(const bf16x8*)(sH + (wq * 32 + r) * 272 + s * 32 + h * 16);
      o = MFMA32(a, bq, o);
    }
    bf16_t* KC = (bf16_t*)(ws + OFF_KCMP);
    int n = half * 64 + wq * 32 + r;
#pragma unroll
    for (int gg = 0; gg < 4; gg++)
      *(uint2*)(KC + ((size_t)((b * 2 + g) * 128 + n)) * 64 + wp * 32 + 8 * gg + 4 * h) = pack4(o[4 * gg], o[4 * gg + 1], o[4 * gg + 2], o[4 * gg + 3]);
  } else {
#pragma unroll
    for (int s = 0; s < 8; s++) {
      bf16x8 a = *(const bf16x8*)(sH + (wp * 32 + r) * 272 + s * 32 + h * 16);
      bf16x8 bq = *(const bf16x8*)(sW + (wq * 32 + r) * 272 + s * 32 + h * 16);
      o = MFMA32(a, bq, o);
    }
    bf16_t* VC = (bf16_t*)(ws + OFF_VCMPT);
    int d = wq * 32 + r;
#pragma unroll
    for (int gg = 0; gg < 4; gg++)
      *(uint2*)(VC + ((size_t)((b * 2 + g) * 64 + d)) * 128 + half * 64 + wp * 32 + 8 * gg + 4 * h) = pack4(o[4 * gg], o[4 * gg + 1], o[4 * gg + 2], o[4 * gg + 3]);
  }
  __syncthreads();
}

template <int DQK, bool ALIBI, class KP, class VP, class NM, class VIS>
DI void attn_loop(const int tid, char* smem, const bf16x8 (&qf)[DQK / 16], int jlo, int jhi, unsigned tmask, int wave_jhi, KP kp, VP vp,
                  const float c1, const float slope2, const int tq, NM needmask, VIS vis, f32x16 (&o)[2], float& m, float& l) {
  constexpr int KROW = DQK * 2 + 16, KSZ = 64 * KROW, VROW = 136  , STG = KSZ + 64 * VROW, KCH = DQK / 8, NKC = KCH / 4;
  const int lane = tid & 63, r = lane & 31, h = lane >> 5;
  u32x4 rk[NKC], rv[2];
  auto nexttile = [&](int from) { while (from <= jhi && !((tmask >> from) & 1u)) from++; return from <= jhi ? from : -1; };
#define ATT_GLOAD(JT) { _Pragma("unroll") for (int i = 0; i < NKC; i++) { int c = tid + 256 * i; int row = c / KCH, kc = c % KCH; rk[i] = *(const u32x4*)kp((JT) * 64 + row, kc); } \
    _Pragma("unroll") for (int i = 0; i < 2; i++) { int c = tid + 256 * i; int row = c >> 3, kc = c & 7; rv[i] = *(const u32x4*)vp(row, (JT) * 64 + kc * 8); } }
#define ATT_SSTORE(ST) { char* st_ = (ST); _Pragma("unroll") for (int i = 0; i < NKC; i++) { int c = tid + 256 * i; int row = c / KCH, kc = c % KCH; *(u32x4*)(st_ + row * KROW + kc * 16) = rk[i]; } \
    _Pragma("unroll") for (int i = 0; i < 2; i++) { int c = tid + 256 * i; int row = c >> 3, kc = c & 7; uint2 lo_, hi_; lo_.x = rv[i].x; lo_.y = rv[i].y; hi_.x = rv[i].z; hi_.y = rv[i].w; \
      *(uint2*)(st_ + KSZ + row * VROW + kc * 16) = lo_; *(uint2*)(st_ + KSZ + row * VROW + kc * 16 + 8) = hi_; } }
  int jt = nexttile(jlo);
  if (jt < 0) return;
  ATT_GLOAD(jt); ATT_SSTORE(smem);
  int jn = nexttile(jt + 1);
  if (jn >= 0) ATT_GLOAD(jn);
  int stg = 0;
  while (true) {
    __syncthreads();
    int jnn = -1;
    if (jn >= 0) { ATT_SSTORE(smem + (stg ^ 1) * STG); jnn = nexttile(jn + 1); if (jnn >= 0) ATT_GLOAD(jnn); }
    __builtin_amdgcn_sched_barrier(0);
    if (jt <= wave_jhi) {
      const char* sK = smem + stg * STG; const char* sV = sK + KSZ;
      f32x16 st[2];
#pragma unroll
      for (int kt = 0; kt < 2; kt++)
#pragma unroll
        for (int i = 0; i < 16; i++) st[kt][i] = 0.f;
#pragma unroll
      for (int s = 0; s < DQK / 16; s++)
#pragma unroll
        for (int kt = 0; kt < 2; kt++) {
          bf16x8 a = *(const bf16x8*)(sK + (32 * kt + r) * KROW + s * 32 + h * 16);
          st[kt] = MFMA32(a, qf[s], st[kt]);
        }
      const bool nmask = needmask(jt);
      float mx = -INFINITY, muse, mnew;
      if (ALIBI) {
        const float tb = slope2 * (float)(jt * 64 + 4 * h - tq);
#pragma unroll
        for (int kt = 0; kt < 2; kt++)
#pragma unroll
          for (int i = 0; i < 16; i++) st[kt][i] = fmaf(st[kt][i], c1, fmaf(slope2, (float)(32 * kt + (i & 3) + 8 * (i >> 2)), tb));
      }
      if (nmask) {
#pragma unroll
        for (int kt = 0; kt < 2; kt++)
#pragma unroll
          for (int i = 0; i < 16; i++) st[kt][i] = vis(jt * 64 + 32 * kt + crow(i, h), jt) ? st[kt][i] : -INFINITY;
      }
#pragma unroll
      for (int kt = 0; kt < 2; kt++)
#pragma unroll
        for (int i = 0; i < 16; i++) mx = fmaxf(mx, st[kt][i]);
      if (!ALIBI) mx *= c1;
      mx = fmaxf(mx, __shfl_xor(mx, 32));
      mnew = fmaxf(m, mx);
      if (__builtin_amdgcn_ballot_w64(mnew > m + 8.f) != 0) {
        float alpha = (mnew == m) ? 1.f : fexp2(m - mnew);
        l *= alpha;
#pragma unroll
        for (int dt = 0; dt < 2; dt++)
#pragma unroll
          for (int i = 0; i < 16; i++) o[dt][i] *= alpha;
        m = mnew;
      }
      muse = (m == -INFINITY) ? 0.f : m;
      float ps = 0.f;
      const float nm = -muse;
#pragma unroll
      for (int kt = 0; kt < 2; kt++)
#pragma unroll
        for (int i = 0; i < 16; i++) { float pv = ALIBI ? fexp2(st[kt][i] + nm) : fexp2(fmaf(st[kt][i], c1, nm)); st[kt][i] = pv; ps += pv; }
      l += ps;
#pragma unroll
      for (int kt = 0; kt < 2; kt++)
#pragma unroll
        for (int s2 = 0; s2 < 2; s2++) {
          bf16x8 pf = pack8(st[kt], 8 * s2);
#pragma unroll
          for (int dt = 0; dt < 2; dt++) {
            bf16x8 vf = ld2x8(sV + (32 * dt + r) * VROW + (32 * kt + 16 * s2 + 4 * h) * 2);
            o[dt] = MFMA32(vf, pf, o[dt]);
          }
        }
    }
    if (jn < 0) break;
    jt = jn; jn = jnn; stg ^= 1;
  }
  __syncthreads();
}

constexpr int NSA_TASKS = 16 * 2 * 64;
DI void nsa_task(const Params& p, char* smem, int idx) {
  char* ws = p.ws;
  const int qb = 63 - (idx >> 5), g = idx & 1, b = (idx >> 1) & 15;
  int tid_ = threadIdx.x; asm volatile("" : "+v"(tid_));
  const int tid = tid_, lane = tid & 63, w = __builtin_amdgcn_readfirstlane(tid >> 6), r = lane & 31, h = lane >> 5;
  const int hq = g * 4 + w;
  const float slope2 = exp2f(-(float)(hq + 1)) * LOG2E;
  const float c1 = 0.125f * LOG2E;
  const int t = qb * 32 + r;
  const size_t tok = (size_t)b * 2048 + t;
  const bf16_t* H0 = (const bf16_t*)(ws + OFF_REGB);
  bf16x8 qf[4];
#pragma unroll
  for (int s = 0; s < 4; s++) qf[s] = *(const bf16x8*)(H0 + tok * H0LD + hq * 64 + 16 * s + 8 * h);
  float gate[3];
#pragma unroll
  for (int br = 0; br < 3; br++) { float gl = bf2f(H0[tok * H0LD + 3328 + br * 8 + hq]); gate[br] = 1.f / (1.f + __expf(-gl)); }
  f32x16 tot[2];
  float* impw = (float*)(smem + 36864);
  unsigned* selmask = (unsigned*)(smem + 36864 + 16896);
  unsigned* umaskp = selmask + 32;
  const int cur = qb >> 1;
  {
    const bf16_t* KC = (const bf16_t*)(ws + OFF_KCMP) + (size_t)(b * 2 + g) * 128 * 64;
    const bf16_t* VC = (const bf16_t*)(ws + OFF_VCMPT) + (size_t)(b * 2 + g) * 64 * 128;
    char* sK = smem; char* sV = smem + 18432;
#pragma unroll
    for (int i = 0; i < 4; i++) { int c = tid + 256 * i; int row = c >> 3, kc = c & 7; *(uint4*)(sK + row * LDS_ROW + kc * 16) = *(const uint4*)(KC + row * 64 + kc * 8); }
#pragma unroll
    for (int i = 0; i < 4; i++) { int c = tid + 256 * i; int row = c >> 4, kc = c & 15; *(uint4*)(sV + row * 272 + kc * 16) = *(const uint4*)(VC + row * 128 + kc * 8); }
    if (tid < 32) selmask[tid] = 0u;
    if (tid == 32) *umaskp = 0u;
    __syncthreads();
    f32x16 st[4];
#pragma unroll
    for (int kt = 0; kt < 4; kt++)
#pragma unroll
      for (int i = 0; i < 16; i++) st[kt][i] = 0.f;
#pragma unroll
    for (int s = 0; s < 4; s++)
#pragma unroll
      for (int kt = 0; kt < 4; kt++) {
        bf16x8 a = *(const bf16x8*)(sK + (32 * kt + r) * LDS_ROW + s * 32 + h * 16);
        st[kt] = MFMA32(a, qf[s], st[kt]);
      }
    float mx = -INFINITY;
#pragma unroll
    for (int kt = 0; kt < 4; kt++)
#pragma unroll
      for (int i = 0; i < 16; i++) {
        int n = 32 * kt + crow(i, h);
        int dist = t - (16 * n + 31);
        float v = (dist >= 0 && n < 127) ? st[kt][i] * c1 - slope2 * (float)dist : -INFINITY;
        st[kt][i] = v; mx = fmaxf(mx, v);
      }
    mx = fmaxf(mx, __shfl_xor(mx, 32));
    float muse = (mx == -INFINITY) ? 0.f : mx;
    float ps = 0.f;
#pragma unroll
    for (int kt = 0; kt < 4; kt++)
#pragma unroll
      for (int i = 0; i < 16; i++) { float pv = fexp2(st[kt][i] - muse); st[kt][i] = pv; ps += pv; }
    ps += __shfl_xor(ps, 32);
    float inv = ps > 0.f ? 1.f / ps : 0.f;
#pragma unroll
    for (int kt = 0; kt < 4; kt++)
#pragma unroll
      for (int i = 0; i < 16; i++) st[kt][i] *= inv;
    {
      float prev = 0.f;
#pragma unroll
      for (int f = 0; f < 16; f++) {
        const int kt = f >> 2, gg = f & 3;
        float p3 = 0.5f * st[kt][4 * gg + 3];
        float mainv = st[kt][4 * gg] + st[kt][4 * gg + 1] + st[kt][4 * gg + 2] + p3;
        float rc = __shfl_xor(p3, 32);
        mainv += (h == 1) ? rc : prev;
        prev = rc;
        impw[(w * 32 + r) * 33 + 2 * f + h] = mainv;
      }
    }
#pragma unroll
    for (int dt = 0; dt < 2; dt++)
#pragma unroll
      for (int i = 0; i < 16; i++) tot[dt][i] = 0.f;
#pragma unroll
    for (int kt = 0; kt < 4; kt++)
#pragma unroll
      for (int s2 = 0; s2 < 2; s2++) {
        bf16x8 pf = pack8(st[kt], 8 * s2);
#pragma unroll
        for (int dt = 0; dt < 2; dt++) {
          bf16x8 vf = ld2x8(sV + (32 * dt + r) * 272 + (32 * kt + 16 * s2 + 4 * h) * 2);
          tot[dt] = MFMA32(vf, pf, tot[dt]);
        }
      }
#pragma unroll
    for (int dt = 0; dt < 2; dt++)
#pragma unroll
      for (int i = 0; i < 16; i++) tot[dt][i] *= gate[0];
    __syncthreads();
    {
      int q = tid >> 3, jq = tid & 7;
#pragma unroll
      for (int e = 0; e < 4; e++) {
        int j = jq * 4 + e;
        float s = impw[(0 * 32 + q) * 33 + j] + impw[(1 * 32 + q) * 33 + j] + impw[(2 * 32 + q) * 33 + j] + impw[(3 * 32 + q) * 33 + j];
        impw[q * 33 + j] = s;
      }
    }
    __syncthreads();
    {
      int q = tid >> 3, jq = tid & 7;
      int nforced = cur == 0 ? 1 : (cur == 1 ? 2 : 3);
      unsigned bits = 0u;
#pragma unroll
      for (int e = 0; e < 4; e++) {
        int j = jq * 4 + e;
        if (j > cur) continue;
        bool forced = (j == 0) || (j == cur) || (j == cur - 1);
        if (forced) { bits |= 1u << j; continue; }
        float v = impw[q * 33 + j];
        int rank = 0;
        for (int j2 = 1; j2 < cur - 1; j2++) {
          float v2 = impw[q * 33 + j2];
          rank += (v2 > v || (v2 == v && j2 < j)) ? 1 : 0;
        }
        if (nforced + rank < 8) bits |= 1u << j;
      }
      if (bits) { atomicOr(&selmask[q], bits); atomicOr(umaskp, bits); }
    }
    __syncthreads();
  }
  const unsigned mysel = selmask[r];
  const unsigned umask = *umaskp;
  unsigned allsel_v = mysel;
#pragma unroll
  for (int off = 16; off >= 1; off >>= 1) allsel_v &= (unsigned)__shfl_xor((int)allsel_v, off);
  const unsigned allsel = __builtin_amdgcn_readfirstlane(allsel_v);
  __syncthreads();
  {
    f32x16 o[2];
#pragma unroll
    for (int dt = 0; dt < 2; dt++)
#pragma unroll
      for (int i = 0; i < 16; i++) o[dt][i] = 0.f;
    float m = -INFINITY, l = 0.f;
    const bf16_t* Kb = H0 + (size_t)b * 2048 * H0LD + 768 + g * 64;
    const bf16_t* Vb = (const bf16_t*)(ws + OFF_VTNSA) + ((size_t)(b * 256 + g * 64)) * 2048;
    attn_loop<64, true>(tid, smem, qf, 0, cur, umask, cur,
                  [&](int key, int kc) { return Kb + (size_t)key * H0LD + kc * 8; },
                  [&](int row, int key) { return Vb + (size_t)row * 2048 + key; },
                  c1, slope2, t,
                  [&](int jt) { return !((allsel >> jt) & 1u) || (jt * 64 + 63 > qb * 32); },
                  [&](int key, int jt) { return ((mysel >> jt) & 1u) && key <= t; },
                  o, m, l);
    l += __shfl_xor(l, 32);
    float sc = l > 0.f ? gate[1] / l : 0.f;
#pragma unroll
    for (int dt = 0; dt < 2; dt++)
#pragma unroll
      for (int i = 0; i < 16; i++) tot[dt][i] += sc * o[dt][i];
  }
  {
    f32x16 o[2];
#pragma unroll
    for (int dt = 0; dt < 2; dt++)
#pragma unroll
      for (int i = 0; i < 16; i++) o[dt][i] = 0.f;
    float m = -INFINITY, l = 0.f;
    const bf16_t* Kb = H0 + (size_t)b * 2048 * H0LD + 1024 + g * 64;
    const bf16_t* Vb = (const bf16_t*)(ws + OFF_VTNSA) + ((size_t)(b * 256 + 128 + g * 64)) * 2048;
    int lo = qb * 32 - 511; lo = lo < 0 ? 0 : (lo >> 6);
    attn_loop<64, true>(tid, smem, qf, lo, cur, 0xffffffffu, cur,
                  [&](int key, int kc) { return Kb + (size_t)key * H0LD + kc * 8; },
                  [&](int row, int key) { return Vb + (size_t)row * 2048 + key; },
                  c1, slope2, t,
                  [&](int jt) { return (qb * 32 + 31 - 64 * jt > 511) || (qb * 32 - 64 * jt - 63 < 0); },
                  [&](int key, int jt) { int dist = t - key; return dist >= 0 && dist < 512; },
                  o, m, l);
    l += __shfl_xor(l, 32);
    float sc = l > 0.f ? gate[2] / l : 0.f;
#pragma unroll
    for (int dt = 0; dt < 2; dt++)
#pragma unroll
      for (int i = 0; i < 16; i++) tot[dt][i] += sc * o[dt][i];
  }
  bf16_t* CAT = (bf16_t*)(ws + OFF_REGD);
#pragma unroll
  for (int dt = 0; dt < 2; dt++)
#pragma unroll
    for (int gg = 0; gg < 4; gg++) {
      int dv = 32 * dt + 8 * gg + 4 * h;
      uint2 z = *(const uint2*)(H0 + tok * H0LD + 1280 + hq * 64 + dv);
      *(uint2*)(CAT + tok * 1024 + hq * 64 + dv) =
          pack4(tot[dt][4 * gg] * silu(bflo(z.x)), tot[dt][4 * gg + 1] * silu(bfhi(z.x)), tot[dt][4 * gg + 2] * silu(bflo(z.y)), tot[dt][4 * gg + 3] * silu(bfhi(z.y)));
    }
}

constexpr int GLA_CHUNK_TASKS = 2048;
DI void gla_a_task(const Params& p, char* smem, int idx) {
  char* ws = p.ws;
  const int chunk = idx & 31, hh = (idx >> 5) & 3, b = idx >> 7;
  int tid_ = threadIdx.x; asm volatile("" : "+v"(tid_));
  const int tid = tid_, lane = tid & 63, w = __builtin_amdgcn_readfirstlane(tid >> 6), r = lane & 31, h = lane >> 5;
  const bf16_t* H0 = (const bf16_t*)(ws + OFF_REGB);
  const bf16_t* VT = (const bf16_t*)(ws + OFF_VTGLA) + ((size_t)(b * 512 + hh * 128)) * 2048;
  char* sQ = smem; char* sK = smem + 9216; char* sKKT = smem + 18432; char* sVT = smem + 27648;
  float* sTot = (float*)(smem + 46080); float* sB = (float*)(smem + 46080 + 1280);
  const int d = tid & 63, cq = w;
  const size_t tok0 = (size_t)b * 2048 + chunk * 64;
  uint4 vreg[4];
#pragma unroll
  for (int i = 0; i < 4; i++) { int c = tid + 256 * i; int row = c >> 3, kc = c & 7; vreg[i] = *(const uint4*)(VT + (size_t)row * 2048 + chunk * 64 + kc * 8); }
  float wg[16];
#pragma unroll
  for (int q = 0; q < 16; q++) wg[q] = p.e_gla_w_gate[q * 256 + hh * 64 + d];
  const float bg = p.e_gla_b_gate[hh * 64 + d];
  float cum[16]; float run = 0.f;
#pragma unroll
  for (int i = 0; i < 16; i++) {
    const bf16_t* gl = H0 + (tok0 + cq * 16 + i) * H0LD + 3360;
    uint4 g0 = *(const uint4*)gl, g1 = *(const uint4*)(gl + 8);
    float a = bg;
    a += bflo(g0.x) * wg[0] + bfhi(g0.x) * wg[1] + bflo(g0.y) * wg[2] + bfhi(g0.y) * wg[3];
    a += bflo(g0.z) * wg[4] + bfhi(g0.z) * wg[5] + bflo(g0.w) * wg[6] + bfhi(g0.w) * wg[7];
    a += bflo(g1.x) * wg[8] + bfhi(g1.x) * wg[9] + bflo(g1.y) * wg[10] + bfhi(g1.y) * wg[11];
    a += bflo(g1.z) * wg[12] + bfhi(g1.z) * wg[13] + bflo(g1.w) * wg[14] + bfhi(g1.w) * wg[15];
    float ls = fminf(a, 0.f) - __logf(1.f + __expf(-fabsf(a)));
    run += ls * (1.f / 16.f);
    cum[i] = run;
  }
  sTot[cq * 64 + d] = run;
  bf16_t qraw[16], kraw[16];
#pragma unroll
  for (int i = 0; i < 16; i++) { size_t tk = tok0 + cq * 16 + i; qraw[i] = H0[tk * H0LD + 1792 + hh * 64 + d]; kraw[i] = H0[tk * H0LD + 2048 + hh * 64 + d]; }
#pragma unroll
  for (int i = 0; i < 4; i++) { int c = tid + 256 * i; int row = c >> 3, kc = c & 7; *(uint4*)(sVT + row * LDS_ROW + kc * 16) = vreg[i]; }
  __syncthreads();
  {
    float t0 = sTot[d], t1 = sTot[64 + d], t2 = sTot[128 + d], t3 = sTot[192 + d];
    float off = cq == 0 ? 0.f : cq == 1 ? t0 : cq == 2 ? t0 + t1 : t0 + t1 + t2;
    float blast = t0 + t1 + t2 + t3;
    bf16_t* QD = (bf16_t*)(ws + OFF_QD);
#pragma unroll
    for (int i = 0; i < 16; i++) {
      int c = cq * 16 + i;
      float bb = cum[i] + off;
      float qv = bf2f(qraw[i]), kv = bf2f(kraw[i]);
      bf16_t qd = (bf16_t)f2bf(qv * 0.125f * __expf(bb));
      ((bf16_t*)(sQ + c * LDS_ROW))[d] = qd;
      QD[(tok0 + c) * 256 + hh * 64 + d] = qd;
      ((bf16_t*)(sK + c * LDS_ROW))[d] = (bf16_t)f2bf(kv * __expf(-bb));
      ((bf16_t*)(sKKT + d * LDS_ROW))[c] = (bf16_t)f2bf(kv * __expf(blast - bb));
    }
    if (cq == 0) ((float*)(ws + OFF_DEC))[(size_t)idx * 64 + d] = __expf(blast);
  }
  __syncthreads();
  f32x16 at0, at1, at2;
#pragma unroll
  for (int i = 0; i < 16; i++) { at0[i] = 0.f; at1[i] = 0.f; at2[i] = 0.f; }
#pragma unroll
  for (int s = 0; s < 4; s++) {
    bf16x8 k0 = *(const bf16x8*)(sK + (r)*LDS_ROW + s * 32 + h * 16);
    bf16x8 k1 = *(const bf16x8*)(sK + (32 + r) * LDS_ROW + s * 32 + h * 16);
    bf16x8 q0 = *(const bf16x8*)(sQ + (r)*LDS_ROW + s * 32 + h * 16);
    bf16x8 q1 = *(const bf16x8*)(sQ + (32 + r) * LDS_ROW + s * 32 + h * 16);
    at0 = MFMA32(k0, q0, at0); at1 = MFMA32(k0, q1, at1); at2 = MFMA32(k1, q1, at2);
  }
#pragma unroll
  for (int i = 0; i < 16; i++) { if (r < crow(i, h)) { at0[i] = 0.f; at2[i] = 0.f; } }
  f32x16 o[2], U[2];
#pragma unroll
  for (int c2 = 0; c2 < 2; c2++)
#pragma unroll
    for (int i = 0; i < 16; i++) { o[c2][i] = 0.f; U[c2][i] = 0.f; }
#pragma unroll
  for (int s2 = 0; s2 < 2; s2++) {
    bf16x8 v0 = ld2x8(sVT + (32 * w + r) * LDS_ROW + (0 + 16 * s2 + 4 * h) * 2);
    bf16x8 v1 = ld2x8(sVT + (32 * w + r) * LDS_ROW + (32 + 16 * s2 + 4 * h) * 2);
    o[0] = MFMA32(pack8(at0, 8 * s2), v0, o[0]);
    o[1] = MFMA32(pack8(at1, 8 * s2), v0, o[1]);
    o[1] = MFMA32(pack8(at2, 8 * s2), v1, o[1]);
  }
#pragma unroll
  for (int dT = 0; dT < 2; dT++)
#pragma unroll
    for (int s4 = 0; s4 < 4; s4++) {
      bf16x8 a = *(const bf16x8*)(sKKT + (32 * dT + r) * LDS_ROW + s4 * 32 + h * 16);
      bf16x8 bq = *(const bf16x8*)(sVT + (32 * w + r) * LDS_ROW + s4 * 32 + h * 16);
      U[dT] = MFMA32(a, bq, U[dT]);
    }
  bf16_t* OI = (bf16_t*)(ws + OFF_OI);
  const int dv = 32 * w + r;
#pragma unroll
  for (int c2 = 0; c2 < 2; c2++)
#pragma unroll
    for (int i = 0; i < 16; i++) OI[(tok0 + 32 * c2 + crow(i, h)) * 512 + hh * 128 + dv] = (bf16_t)f2bf(o[c2][i]);
  float* UPD = (float*)(ws + OFF_UPD) + ((size_t)idx * 128 + dv) * 64;
#pragma unroll
  for (int dT = 0; dT < 2; dT++)
#pragma unroll
    for (int gg = 0; gg < 4; gg++) {
      float4 u; u.x = U[dT][4 * gg]; u.y = U[dT][4 * gg + 1]; u.z = U[dT][4 * gg + 2]; u.w = U[dT][4 * gg + 3];
      *(float4*)(UPD + 32 * dT + 8 * gg + 4 * h) = u;
    }
  __syncthreads();
}

constexpr int GLA_B_TASKS = 512;
DI void gla_b_task(const Params& p, int idx) {
  char* ws = p.ws;
  const int gid = idx * 256 + threadIdx.x;
  const int bh = gid >> 11, dv = (gid >> 4) & 127, dq = gid & 15;
  const float* UPD = (const float*)(ws + OFF_UPD) + ((size_t)bh * 32 * 128 + dv) * 64 + dq * 4;
  const float* DEC = (const float*)(ws + OFF_DEC) + (size_t)bh * 32 * 64 + dq * 4;
  bf16_t* ST = (bf16_t*)(ws + OFF_ST) + ((size_t)bh * 32 * 128 + dv) * 64 + dq * 4;
  float4 s = {0.f, 0.f, 0.f, 0.f};
#pragma unroll 1
  for (int n0 = 0; n0 < 32; n0 += 8) {
    float4 u[8], dc[8];
#pragma unroll
    for (int q = 0; q < 8; q++) { u[q] = *(const float4*)(UPD + (size_t)(n0 + q) * 128 * 64); dc[q] = *(const float4*)(DEC + (n0 + q) * 64); }
#pragma unroll
    for (int q = 0; q < 8; q++) {
      *(uint2*)(ST + (size_t)(n0 + q) * 128 * 64) = pack4(s.x, s.y, s.z, s.w);
      s.x = dc[q].x * s.x + u[q].x; s.y = dc[q].y * s.y + u[q].y; s.z = dc[q].z * s.z + u[q].z; s.w = dc[q].w * s.w + u[q].w;
    }
  }
}

DI void gla_c_task(const Params& p, char* smem, int idx) {
  char* ws = p.ws;
  const int chunk = idx & 31, hh = (idx >> 5) & 3, b = idx >> 7;
  int tid_ = threadIdx.x; asm volatile("" : "+v"(tid_));
  const int tid = tid_, lane = tid & 63, w = __builtin_amdgcn_readfirstlane(tid >> 6), r = lane & 31, h = lane >> 5;
  const bf16_t* H0 = (const bf16_t*)(ws + OFF_REGB);
  const bf16_t* QD = (const bf16_t*)(ws + OFF_QD);
  const bf16_t* ST = (const bf16_t*)(ws + OFF_ST) + (size_t)idx * 128 * 64;
  const bf16_t* OI = (const bf16_t*)(ws + OFF_OI);
  bf16_t* CAT = (bf16_t*)(ws + OFF_REGD);
  char* sQ = smem; char* sS = smem + 9216; float* sO = (float*)(smem + 27648);
  const size_t tok0 = (size_t)b * 2048 + chunk * 64;
#pragma unroll
  for (int i = 0; i < 2; i++) { int c = tid + 256 * i; int row = c >> 3, kc = c & 7; *(uint4*)(sQ + row * LDS_ROW + kc * 16) = *(const uint4*)(QD + (tok0 + row) * 256 + hh * 64 + kc * 8); }
#pragma unroll
  for (int i = 0; i < 4; i++) { int c = tid + 256 * i; int row = c >> 3, kc = c & 7; *(uint4*)(sS + row * LDS_ROW + kc * 16) = *(const uint4*)(ST + row * 64 + kc * 8); }
  const int dv = 32 * w + r;
  float oi[2][16];
#pragma unroll
  for (int c2 = 0; c2 < 2; c2++)
#pragma unroll
    for (int i = 0; i < 16; i++) oi[c2][i] = bf2f(OI[(tok0 + 32 * c2 + crow(i, h)) * 512 + hh * 128 + dv]);
  __syncthreads();
  f32x16 o[2];
#pragma unroll
  for (int c2 = 0; c2 < 2; c2++)
#pragma unroll
    for (int i = 0; i < 16; i++) o[c2][i] = oi[c2][i];
#pragma unroll
  for (int s = 0; s < 4; s++) {
    bf16x8 bq = *(const bf16x8*)(sS + (32 * w + r) * LDS_ROW + s * 32 + h * 16);
#pragma unroll
    for (int c2 = 0; c2 < 2; c2++) {
      bf16x8 a = *(const bf16x8*)(sQ + (32 * c2 + r) * LDS_ROW + s * 32 + h * 16);
      o[c2] = MFMA32(a, bq, o[c2]);
    }
  }
#pragma unroll
  for (int c2 = 0; c2 < 2; c2++)
#pragma unroll
    for (int i = 0; i < 16; i++) sO[(32 * c2 + crow(i, h)) * 129 + dv] = o[c2][i];
  __syncthreads();
  {
    int c = tid >> 2, part = tid & 3; size_t tk = tok0 + c;
    float ssq = 0.f;
#pragma unroll
    for (int i4 = 0; i4 < 4; i4++)
#pragma unroll
      for (int e = 0; e < 8; e++) { float v = sO[c * 129 + (i4 * 4 + part) * 8 + e]; ssq += v * v; }
    ssq += __shfl_xor(ssq, 1); ssq += __shfl_xor(ssq, 2);
    float rinv = rsqrtf(ssq * (1.f / 128.f) + EPS);
#pragma unroll
    for (int i4 = 0; i4 < 4; i4++) {
      int dv0 = (i4 * 4 + part) * 8;
      uint4 z = *(const uint4*)(H0 + tk * H0LD + 2816 + hh * 128 + dv0);
      const float* ng = p.e_gla_norm + dv0; const float* so = sO + c * 129 + dv0;
      uint4 ov;
      ov.x = pack2(so[0] * rinv * ng[0] * silu(bflo(z.x)), so[1] * rinv * ng[1] * silu(bfhi(z.x)));
      ov.y = pack2(so[2] * rinv * ng[2] * silu(bflo(z.y)), so[3] * rinv * ng[3] * silu(bfhi(z.y)));
      ov.z = pack2(so[4] * rinv * ng[4] * silu(bflo(z.z)), so[5] * rinv * ng[5] * silu(bfhi(z.z)));
      ov.w = pack2(so[6] * rinv * ng[6] * silu(bflo(z.w)), so[7] * rinv * ng[7] * silu(bfhi(z.w)));
      *(uint4*)(CAT + tk * 1024 + 512 + hh * 128 + dv0) = ov;
    }
  }
  __syncthreads();
}

constexpr int OP_TILES = 256 * 8;
DI void outproj_tile(const Params& p, char* smem, int tm, int tn, int layer) {
  char* ws = p.ws;
  const int tid = threadIdx.x, lane = tid & 63, w = __builtin_amdgcn_readfirstlane(tid >> 6), wp = w >> 1, wq = w & 1, r = lane & 31, h = lane >> 5;
  const int t0 = tm * 128, n0 = tn * 128;
  SrcRM sc{(const bf16_t*)(ws + OFF_REGD), 1024}, sw{(const bf16_t*)(ws + (layer ? OFF_WT_OUT1 : OFF_WT_OUT0)), 1024};
  const float* xres = layer ? p.out : p.x;
  float* Y = (float*)(ws + OFF_REGB);
  f32x16 acc[2][2];
  gemm_tile<2, 2>(smem, sw, n0, sc, t0, 1024, acc);
  epi_store_f32_resid(smem, acc, Y + (size_t)t0 * 1024 + n0, xres + (size_t)t0 * 1024 + n0, 1024);
}
constexpr int LN_TASKS = T / 64;
DI void ln_task(const Params& p, int idx, int layer) {
  char* ws = p.ws;
  const int tid = threadIdx.x, lane = tid & 63, w = __builtin_amdgcn_readfirstlane(tid >> 6);
  const float* Y = (const float*)(ws + OFF_REGB);
  const float* lg = layer ? p.o_ln_g : p.e_ln_g; const float* lb = layer ? p.o_ln_b : p.e_ln_b;
  bf16_t* X1B = (bf16_t*)(ws + OFF_REGF);
  float4 gv[4], bv[4];
#pragma unroll
  for (int q = 0; q < 4; q++) { gv[q] = *(const float4*)(lg + q * 256 + lane * 4); bv[q] = *(const float4*)(lb + q * 256 + lane * 4); }
#pragma unroll 4
  for (int rr = 0; rr < 16; rr++) {
    size_t tok = (size_t)idx * 64 + w * 16 + rr;
    float4 v[4];
    float sum = 0.f;
#pragma unroll
    for (int q = 0; q < 4; q++) { v[q] = *(const float4*)(Y + tok * 1024 + q * 256 + lane * 4); sum += v[q].x + v[q].y + v[q].z + v[q].w; }
#pragma unroll
    for (int o = 32; o >= 1; o >>= 1) sum += __shfl_xor(sum, o);
    float mean = sum * (1.f / 1024.f);
    float sq = 0.f;
#pragma unroll
    for (int q = 0; q < 4; q++) sq += v[q].x * v[q].x + v[q].y * v[q].y + v[q].z * v[q].z + v[q].w * v[q].w;
#pragma unroll
    for (int o = 32; o >= 1; o >>= 1) sq += __shfl_xor(sq, o);
    sq = fmaxf(sq - 1024.f * mean * mean, 0.f);
#pragma unroll
    for (int q = 0; q < 4; q++) { v[q].x -= mean; v[q].y -= mean; v[q].z -= mean; v[q].w -= mean; }
    float rstd = rsqrtf(sq * (1.f / 1024.f) + EPS);
#pragma unroll
    for (int q = 0; q < 4; q++) {
      int n = q * 256 + lane * 4;
      float4 ov;
      ov.x = v[q].x * rstd * gv[q].x + bv[q].x; ov.y = v[q].y * rstd * gv[q].y + bv[q].y; ov.z = v[q].z * rstd * gv[q].z + bv[q].z; ov.w = v[q].w * rstd * gv[q].w + bv[q].w;
      *(float4*)(p.out + tok * 1024 + n) = ov;
      if (!layer) *(uint2*)(X1B + tok * 1024 + n) = pack4(ov.x, ov.y, ov.z, ov.w);
    }
  }
}

constexpr int P5_TOTAL = 256 * 14;
DI void p5_tile(const Params& p, char* smem, int tm, int tn) {
  char* ws = p.ws;
  const int tid = threadIdx.x, lane = tid & 63, w = __builtin_amdgcn_readfirstlane(tid >> 6), wp = w >> 1, wq = w & 1, r = lane & 31, h = lane >> 5;
  SrcRM sx{(const bf16_t*)(ws + OFF_REGF), 1024}, sw{(const bf16_t*)(ws + OFF_WT_IN1), 1024};
  bf16_t* H1 = (bf16_t*)(ws + OFF_H1);
  f32x16 acc[2][2];
  const int t0 = tm * 128, n0 = tn * 128;
  gemm_tile<2, 2>(smem, sw, n0, sx, t0, 1024, acc);
  if (tn == 13 && wp == 0) {
    bf16_t* KR = (bf16_t*)(ws + OFF_KR);
#pragma unroll
    for (int iq = 0; iq < 2; iq++) {
      const size_t tok = (size_t)t0 + (wq * 2 + iq) * 32 + r;
      const float pos = (float)(int)(tok & 2047);
#pragma unroll
      for (int i = 0; i < 8; i++) {
        const int d = crow(i, h);
        float freq = expf(-9.210340371976184f * ((float)d * (1.f / 16.f)));
        float ang = pos * freq; float sn = __sinf(ang), cs = __cosf(ang);
        float x1 = __uint_as_float(f2bf(acc[0][iq][i]) << 16), x2 = __uint_as_float(f2bf(acc[0][iq][i + 8]) << 16);
        KR[tok * 32 + d] = (bf16_t)f2bf(x1 * cs - x2 * sn);
        KR[tok * 32 + 16 + d] = (bf16_t)f2bf(x2 * cs + x1 * sn);
      }
    }
  }
  epi_store_bf16_ssq(smem, acc, H1 + (size_t)t0 * H1LD + n0, H1LD, H1LD - n0, tn < 5 ? (float*)(ws + OFF_SSQ) + (size_t)tn * T + t0 : nullptr);
}

constexpr int P6_Q = 256 * 12, P6_TOTAL = P6_Q + 256 * 16;
DI void p6_task(const Params& p, char* smem, const bool isq, int tm, int tn) {
  char* ws = p.ws;
  const int tid = threadIdx.x, lane = tid & 63, w = __builtin_amdgcn_readfirstlane(tid >> 6), wp = w >> 1, wq = w & 1, r = lane & 31, h = lane >> 5;
  const bf16_t* H1 = (const bf16_t*)(ws + OFF_H1);
  const int t0 = tm * 128, n0 = tn * 128;
  const int KD = isq ? 384 : 256, coff = isq ? 0 : 384;
  float* sRinv = (float*)(smem + 73728);
  if (tid < 128) {
    const float* sq = (const float*)(ws + OFF_SSQ) + (size_t)(t0 + tid);
    sRinv[tid] = isq ? rsqrtf((sq[0] + sq[T] + sq[2 * (size_t)T]) * (1.f / 384.f) + EPS) : rsqrtf((sq[3 * (size_t)T] + sq[4 * (size_t)T]) * (1.f / 256.f) + EPS);
  }
  __syncthreads();
  SrcRM sa{H1 + coff, H1LD};
  f32x16 acc[2][2];
  {
    SrcRM sw{(const bf16_t*)(ws + (isq ? OFF_WT_UQ : OFF_WT_UKV)), KD};
    const bool trv = !isq && tn >= 8;
    gemm_tile<2, 2>(smem, trv ? sa : sw, trv ? t0 : n0, trv ? sw : sa, trv ? n0 : t0, KD, acc);
  }
  if (isq || tn < 8) {
    const float qs = isq ? 0.10206207261596575f : 1.f;
#pragma unroll
    for (int iq = 0; iq < 2; iq++) {
      float sc = sRinv[(wq * 2 + iq) * 32 + r] * qs;
#pragma unroll
      for (int ip = 0; ip < 2; ip++)
#pragma unroll
        for (int i = 0; i < 16; i++) acc[ip][iq][i] *= sc;
    }
    if (isq) epi_store_bf16(smem, acc, (bf16_t*)(ws + OFF_Q1) + (size_t)t0 * 1536 + n0, 1536, 128);
    else epi_store_bf16(smem, acc, (bf16_t*)(ws + OFF_K1) + (size_t)t0 * 1024 + n0, 1024, 128);
  } else {
#pragma unroll
    for (int ip = 0; ip < 2; ip++)
#pragma unroll
      for (int i = 0; i < 16; i++) {
        float sc = sRinv[(wp * 2 + ip) * 32 + crow(i, h)];
#pragma unroll
        for (int iq = 0; iq < 2; iq++) acc[ip][iq][i] *= sc;
      }
    const int b = t0 >> 11, s0 = t0 & 2047;
    epi_store_bf16(smem, acc, (bf16_t*)(ws + OFF_REGF) + ((size_t)(b * 1024 + (n0 - 1024))) * 2048 + s0, 2048, 128);
  }
}

constexpr int P7_TOTAL = 16 * 16 * 16;
DI void mla_task(const Params& p, char* smem, int idx) {
  char* ws = p.ws;
  const int qblk = 15 - (idx >> 8), hd = idx & 15, b = (idx >> 4) & 15;
  int tid_ = threadIdx.x; asm volatile("" : "+v"(tid_));
  const int tid = tid_, lane = tid & 63, w = __builtin_amdgcn_readfirstlane(tid >> 6), r = lane & 31, h = lane >> 5;
  const int t = qblk * 128 + w * 32 + r;
  const size_t tok = (size_t)b * 2048 + t;
  const bf16_t* Q1 = (const bf16_t*)(ws + OFF_Q1);
  const bf16_t* H1 = (const bf16_t*)(ws + OFF_H1);
  bf16x8 qf[6];
#pragma unroll
  for (int s = 0; s < 6; s++) qf[s] = *(const bf16x8*)(Q1 + tok * 1536 + hd * 96 + 16 * s + 8 * h);
  {
    union { bf16x8 v; unsigned short e[8]; } a, c;
    a.v = qf[4]; c.v = qf[5];
#pragma unroll
    for (int j = 0; j < 8; j++) {
      float freq = expf(-9.210340371976184f * ((float)(8 * h + j) * (1.f / 16.f)));
      float ang = (float)t * freq; float sn = __sinf(ang), cs = __cosf(ang);
      float x1 = bf2f(a.e[j]), x2 = bf2f(c.e[j]);
      a.e[j] = (unsigned short)f2bf(x1 * cs - x2 * sn);
      c.e[j] = (unsigned short)f2bf(x2 * cs + x1 * sn);
    }
    qf[4] = a.v; qf[5] = c.v;
  }
  f32x16 o[2];
#pragma unroll
  for (int dt = 0; dt < 2; dt++)
#pragma unroll
    for (int i = 0; i < 16; i++) o[dt][i] = 0.f;
  float m = -INFINITY, l = 0.f;
  const bf16_t* Kb = (const bf16_t*)(ws + OFF_K1) + (size_t)b * 2048 * 1024 + hd * 64;
  const bf16_t* KRb = (const bf16_t*)(ws + OFF_KR) + (size_t)b * 2048 * 32;
  const bf16_t* Vb = (const bf16_t*)(ws + OFF_REGF) + ((size_t)(b * 1024 + hd * 64)) * 2048;
  const int jhi = (qblk * 128 + 127) >> 6, wjhi = (qblk * 128 + w * 32 + 31) >> 6;
  const int tmin = qblk * 128 + w * 32;
  attn_loop<96, false>(tid, smem, qf, 0, jhi, 0xffffffffu, wjhi,
                [&](int key, int kc) { return kc < 8 ? Kb + (size_t)key * 1024 + kc * 8 : KRb + (size_t)key * 32 + (kc - 8) * 8; },
                [&](int row, int key) { return Vb + (size_t)row * 2048 + key; },
                LOG2E, 0.f, t,
                [&](int jt) { return jt * 64 + 63 > tmin; },
                [&](int key, int jt) { return key <= t; },
                o, m, l);
  l += __shfl_xor(l, 32);
  float inv = l > 0.f ? 1.f / l : 0.f;
  bf16_t* CAT = (bf16_t*)(ws + OFF_REGD);
#pragma unroll
  for (int dt = 0; dt < 2; dt++)
#pragma unroll
    for (int gg = 0; gg < 4; gg++) {
      int dv = 32 * dt + 8 * gg + 4 * h;
      uint2 z = *(const uint2*)(H1 + tok * H1LD + 640 + hd * 64 + dv);
      *(uint2*)(CAT + tok * 1024 + hd * 64 + dv) =
          pack4(o[dt][4 * gg] * inv * silu(bflo(z.x)), o[dt][4 * gg + 1] * inv * silu(bfhi(z.x)), o[dt][4 * gg + 2] * inv * silu(bflo(z.y)), o[dt][4 * gg + 3] * inv * silu(bfhi(z.y)));
    }
}


#define XB_TMO      128
#define XB_XCNT(j)  (256  + 64 * (j))
#define XB_XSUB(j)  (1280 + 64 * (j))
#define XB_XGEN(j)  (2304 + 64 * (j))
#define XB_TOP      3328
#define XB_TOPGEN   3392
#define XCD_BAR_WORDS 3456
#define XB_SPIN_CAP (1u << 18)
#define LAS __attribute__((address_space(3)))
DI unsigned xb_ld(unsigned* p) { return __hip_atomic_load(p, __ATOMIC_RELAXED, __HIP_MEMORY_SCOPE_AGENT); }
DI unsigned xb_add(unsigned* p, unsigned v) { return __hip_atomic_fetch_add(p, v, __ATOMIC_RELAXED, __HIP_MEMORY_SCOPE_AGENT); }
DI unsigned xb_xcc_id() { return (unsigned)__builtin_amdgcn_s_getreg((3 << 11) | 20) & 0xFu; }
#define XB_SPIN(cond, bar) do { unsigned _sp = 0; while (cond) { __builtin_amdgcn_s_sleep(1); \
    if ((++_sp & 255u) == 0u) { if (xb_ld(&(bar)[XB_TMO])) break; if (_sp > XB_SPIN_CAP) { atomicAdd(&(bar)[XB_TMO], 1u); break; } } } } while (0)
struct XcdBarrier { unsigned* bar; unsigned x; volatile LAS unsigned* st; };
DI XcdBarrier xcd_barrier_post(unsigned* bar, volatile LAS unsigned* st) {
  XcdBarrier b; b.bar = bar; b.x = xb_xcc_id(); b.st = st;
  if (threadIdx.x == 0) (void)xb_add(&bar[XB_XCNT(b.x)], 1u);
  return b;
}
DI void xcd_barrier_complete(unsigned* bar, unsigned x, unsigned& nloc, unsigned& nx) {
  const unsigned G = gridDim.x * gridDim.y * gridDim.z;
  unsigned sum, cnt, mine, sp = 0u;
  for (;;) {
    sum = 0u; cnt = 0u; mine = 0u;
#pragma unroll
    for (unsigned j = 0; j < 16; ++j) { const unsigned c = xb_ld(&bar[XB_XCNT(j)]); sum += c; cnt += (c > 0u) ? 1u : 0u; mine = (j == x) ? c : mine; }
    if (sum == G) break;
    __builtin_amdgcn_s_sleep(1);
    if ((++sp & 255u) == 0u) { if (xb_ld(&bar[XB_TMO])) break; if (sp > XB_SPIN_CAP) { atomicAdd(&bar[XB_TMO], 1u); break; } }
  }
  nloc = mine > 0u ? mine : 1u; nx = cnt > 0u ? cnt : 1u;
}
DI void xcd_barrier(const XcdBarrier& b) {
  asm volatile("s_waitcnt vmcnt(0)" ::: "memory");
  __syncthreads();
  if (threadIdx.x == 0) {
    unsigned* bar = b.bar;
    __builtin_amdgcn_s_waitcnt(0);
    unsigned nloc = b.st[0], nx = b.st[1];
    if (nloc == 0u) { xcd_barrier_complete(bar, b.x, nloc, nx); b.st[0] = nloc; b.st[1] = nx; }
    const unsigned old = xb_add(&bar[XB_XSUB(b.x)], 1u);
    const unsigned gen = old / nloc;
    if (old + 1u == (gen + 1u) * nloc) {
      __builtin_amdgcn_fence(__ATOMIC_RELEASE, "agent");
      asm volatile("s_waitcnt vmcnt(0)" ::: "memory");
      const unsigned og = xb_add(&bar[XB_TOP], 1u);
      const unsigned tg = og / nx;
      if (og + 1u == (tg + 1u) * nx) xb_add(&bar[XB_TOPGEN], 1u);
      else XB_SPIN(xb_ld(&bar[XB_TOPGEN]) == tg, bar);
      __builtin_amdgcn_fence(__ATOMIC_ACQUIRE, "agent");
      xb_add(&bar[XB_XGEN(b.x)], 1u);
      asm volatile("s_waitcnt vmcnt(0)" ::: "memory");
    } else {
      XB_SPIN(xb_ld(&bar[XB_XGEN(b.x)]) == gen, bar);
      __builtin_amdgcn_fence(__ATOMIC_ACQUIRE, "agent");
      asm volatile("s_waitcnt vmcnt(0)" ::: "memory");
    }
  }
  __syncthreads();
}

__global__ void __launch_bounds__(256, 2) nsa_gla_mla_mega(Params p) {
  __shared__ __attribute__((aligned(16))) char smem[SMEM_BYTES];
  __shared__ int s_task;
  __shared__ uint4 xb_words;
  cg::grid_group grid = cg::this_grid();
  if (threadIdx.x == 0) xb_words = make_uint4(0u, 0u, 0u, 0u);
  __syncthreads();
  XcdBarrier xb = xcd_barrier_post((unsigned*)(p.ws + OFF_CTR), (volatile LAS unsigned*)&xb_words);
  if (p.phase_end == 12345) grid.sync();
  int* ctr = (int*)(p.ws + OFF_CTR + 14336);
#ifndef SKIPMASK
#define SKIPMASK 0
#endif
#define PHASE_ON(n) (!((SKIPMASK >> (n)) & 1) && p.phase_begin <= (n) && (n) < p.phase_end)
#define PHASE_SYNC(n) if (p.phase_begin <= (n) && (n) + 1 < p.phase_end) xcd_barrier(xb);
#ifndef DUPMASK
#define DUPMASK 0
#endif
#define NREP(n) (1 + ((DUPMASK >> (n)) & 1))
#define XCD_TILE_LOOP(RT, CT, RS, CS, CALL) { const int x_ = blockIdx.x & 7, rs_ = x_ / (CS), cs_ = x_ % (CS); const int nr_ = (RT) / (RS), r0_ = rs_ * nr_; \
    const int c0_ = (cs_ * (CT)) / (CS), nc_ = ((cs_ + 1) * (CT)) / (CS) - c0_; \
    for (int j_ = blockIdx.x >> 3; j_ < nr_ * nc_; j_ += gridDim.x >> 3) { const int tm = r0_ + j_ / nc_, tn = c0_ + j_ % nc_; CALL; } }
#define QUEUE_LOOP(CTR, NTASK, CALL) for (;;) { if (threadIdx.x == 0) s_task = atomicAdd(&ctr[CTR], 1); __syncthreads(); int tk = s_task; __syncthreads(); if (tk >= (NTASK)) break; CALL; __syncthreads(); }
  if (PHASE_ON(0)) for (int rep = 0; rep < NREP(0); rep++) for (int i = blockIdx.x; i < P0_TOTAL; i += gridDim.x) p0_task(p, smem, i);
  PHASE_SYNC(0)
  if (PHASE_ON(1)) for (int rep = 0; rep < NREP(1); rep++) XCD_TILE_LOOP(256, 27, 2, 4, p1_tile(p, smem, tm, tn))
  PHASE_SYNC(1)
  if (PHASE_ON(2)) for (int rep = 0; rep < NREP(2); rep++) {
    QUEUE_LOOP(3 + 8 * rep, P2_TOTAL, p2_task(p, smem, tk))
    QUEUE_LOOP(4 + 8 * rep, GLA_CHUNK_TASKS, gla_a_task(p, smem, tk))
  }
  PHASE_SYNC(2)
  if (PHASE_ON(3)) for (int rep = 0; rep < NREP(3); rep++) {
    QUEUE_LOOP(0 + 8 * rep, GLA_B_TASKS, gla_b_task(p, tk))
    QUEUE_LOOP(2 + 8 * rep, NSA_TASKS, nsa_task(p, smem, tk))
  }
  PHASE_SYNC(3)
  if (PHASE_ON(4)) for (int rep = 0; rep < NREP(4); rep++) for (int i = blockIdx.x; i < GLA_CHUNK_TASKS; i += gridDim.x) gla_c_task(p, smem, i);
  PHASE_SYNC(4)
  if (PHASE_ON(5)) for (int rep = 0; rep < NREP(5); rep++) XCD_TILE_LOOP(256, 8, 8, 1, outproj_tile(p, smem, tm, tn, 0))
  PHASE_SYNC(5)
  if (PHASE_ON(6)) for (int rep = 0; rep < NREP(6); rep++) for (int i = blockIdx.x; i < LN_TASKS; i += gridDim.x) ln_task(p, i, 0);
  PHASE_SYNC(6)
  if (PHASE_ON(7)) for (int rep = 0; rep < NREP(7); rep++) XCD_TILE_LOOP(256, 14, 4, 2, p5_tile(p, smem, tm, tn))
  PHASE_SYNC(7)
  if (PHASE_ON(9)) for (int rep = 0; rep < NREP(9); rep++) { XCD_TILE_LOOP(256, 16, 8, 1, p6_task(p, smem, false, tm, tn)) XCD_TILE_LOOP(256, 12, 8, 1, p6_task(p, smem, true, tm, tn)) }
  PHASE_SYNC(9)
  if (PHASE_ON(10)) for (int rep = 0; rep < NREP(10); rep++) {
    QUEUE_LOOP(1 + 8 * rep, P7_TOTAL, mla_task(p, smem, tk))
  }
  PHASE_SYNC(10)
  if (PHASE_ON(11)) XCD_TILE_LOOP(256, 8, 8, 1, outproj_tile(p, smem, tm, tn, 1))
  PHASE_SYNC(11)
  if (PHASE_ON(12)) for (int i = blockIdx.x; i < LN_TASKS; i += gridDim.x) ln_task(p, i, 1);
}

#ifndef N_LAUNCH_SPLIT
#define N_LAUNCH_SPLIT 0
#endif

extern "C" void kernel_launch(void* const* d_in, const int* in_sizes, int n_in, void* d_out, int out_size, void* d_ws, size_t ws_size,
                              hipStream_t stream) {
  static int grid_blocks = 0;
  if (!grid_blocks) {
    int dev = 0, cus = 0, per_cu = 0;
    hipGetDevice(&dev);
    hipDeviceGetAttribute(&cus, hipDeviceAttributeMultiprocessorCount, dev);
    hipOccupancyMaxActiveBlocksPerMultiprocessor(&per_cu, nsa_gla_mla_mega, 256, 0);
    if (per_cu < 1) per_cu = 1;
    if (per_cu > 2) per_cu = 2;
    grid_blocks = cus * per_cu;
  }
  Params p{};
  const float** f = (const float**)&p;
  for (int i = 0; i < 19; i++) f[i] = (const float*)d_in[i];
  p.out = (float*)d_out;
  p.ws = (char*)d_ws;
  (void)hipMemsetAsync((char*)d_ws + OFF_CTR, 0, 16384, stream);
#if N_LAUNCH_SPLIT
  for (int ph = 0; ph < 13; ph++) {
    p.phase_begin = ph; p.phase_end = ph + 1;
    hipLaunchKernelGGL(nsa_gla_mla_mega, dim3(grid_blocks), dim3(256), 0, stream, p);
  }
#else
  p.phase_begin = 0; p.phase_end = 13;
  void* args[] = {&p};
  hipError_t e = hipLaunchCooperativeKernel((void*)nsa_gla_mla_mega, dim3(grid_blocks), dim3(256), args, 0, stream);
  if (e != hipSuccess) fprintf(stderr, "cooperative launch failed: %s (grid %d)\n", hipGetErrorString(e), grid_blocks);
#endif
}
```

```cpp
#include <hip/hip_runtime.h>
#include <hip/hip_cooperative_groups.h>
#include <cstdio>
namespace cg = cooperative_groups;

#define DI __device__ __forceinline__
typedef unsigned short bf16_t;
typedef __attribute__((ext_vector_type(8))) short bf16x8;
typedef __attribute__((ext_vector_type(4))) short s16x4;
typedef __attribute__((ext_vector_type(16))) float f32x16;
typedef __attribute__((ext_vector_type(4))) unsigned u32x4;
#define MFMA32(a, b, c) __builtin_amdgcn_mfma_f32_32x32x16_bf16((a), (b), (c), 0, 0, 0)

constexpr int S = 2048, T = 16 * 2048;
constexpr int H0LD = 3392, H0N = 3456, H1LD = 1696, H1N = 1792;
constexpr int LDS_ROW = 144;
constexpr float LOG2E = 1.4426950408889634f;
constexpr float ALPHA = 1.4142135623730951f;
constexpr float EPS = 1e-5f;

constexpr size_t al256(size_t x) { return (x + 255) & ~size_t(255); }
constexpr size_t OFF_CTR = 0;
constexpr size_t OFF_WT_IN0 = 16384;
constexpr size_t OFF_WT_OUT0 = OFF_WT_IN0 + (size_t)H0N * 1024 * 2;
constexpr size_t OFF_WT_IN1 = OFF_WT_OUT0 + (size_t)1024 * 1024 * 2;
constexpr size_t OFF_WT_UQ = OFF_WT_IN1 + (size_t)H1N * 1024 * 2;
constexpr size_t OFF_WT_UKV = OFF_WT_UQ + (size_t)1536 * 384 * 2;
constexpr size_t OFF_WT_OUT1 = OFF_WT_UKV + (size_t)2048 * 256 * 2;
constexpr size_t OFF_W1T = OFF_WT_OUT1 + (size_t)1024 * 1024 * 2;
constexpr size_t OFF_W2T = OFF_W1T + (size_t)2 * 128 * 2048 * 2;
constexpr size_t OFF_BIAS1 = OFF_W2T + (size_t)2 * 64 * 128 * 2;
constexpr size_t OFF_REGB = al256(OFF_BIAS1 + 2 * 128 * 4);
constexpr size_t REGB_SZ = (size_t)T * H0LD * 2;
constexpr size_t OFF_H1 = OFF_REGB;
constexpr size_t OFF_Q1 = OFF_REGB + al256((size_t)T * H1LD * 2);
constexpr size_t OFF_REGC = OFF_REGB + REGB_SZ;
constexpr size_t OFF_VTNSA = OFF_REGC;
constexpr size_t OFF_VTGLA = OFF_VTNSA + (size_t)16 * 256 * 2048 * 2;
constexpr size_t OFF_KCMP = OFF_VTGLA + (size_t)16 * 512 * 2048 * 2;
constexpr size_t OFF_VCMPT = OFF_KCMP + (size_t)16 * 2 * 128 * 64 * 2;
constexpr size_t OFF_K1 = OFF_REGC;
constexpr size_t OFF_REGD = OFF_REGC + (size_t)T * 1024 * 2;
constexpr size_t OFF_REGF = OFF_REGD + (size_t)T * 1024 * 2;
constexpr size_t OFF_KR = OFF_REGF + (size_t)T * 1024 * 2;
constexpr size_t OFF_RINV = OFF_KR + (size_t)T * 32 * 2;
constexpr size_t OFF_QD = OFF_RINV + (size_t)T * 2 * 4;
constexpr size_t OFF_OI = OFF_QD + (size_t)T * 256 * 2;
constexpr size_t OFF_ST = OFF_OI + (size_t)T * 512 * 2;
constexpr size_t OFF_DEC = OFF_ST + (size_t)2048 * 128 * 64 * 2;
constexpr size_t OFF_UPD = OFF_REGF;
constexpr size_t OFF_SSQ = OFF_DEC + (size_t)2048 * 64 * 4;
constexpr size_t WS_TOTAL = OFF_SSQ + (size_t)T * 8 * 4;
static_assert(WS_TOTAL <= (size_t)536870912, "ws budget");
static_assert(OFF_Q1 + (size_t)T * 1536 * 2 <= OFF_REGC, "regB");
static_assert(OFF_VCMPT + (size_t)16 * 2 * 64 * 128 * 2 <= OFF_REGD, "regC");

constexpr int SMEM_BYTES = 73728 + 1024 + 64;

struct Params {
  const float *x, *e_w_in, *e_cmp_pe, *e_cmp_w1, *e_cmp_w2, *e_gla_w_gate, *e_gla_b_gate, *e_gla_norm, *e_w_out, *e_ln_g, *e_ln_b;
  const float *o_w_in, *o_q_norm, *o_w_uq, *o_kv_norm, *o_w_ukv, *o_w_out, *o_ln_g, *o_ln_b;
  float* out;
  char* ws;
  int phase_begin, phase_end;
};

typedef __bf16 bf2_t __attribute__((ext_vector_type(2)));
typedef float f2_t __attribute__((ext_vector_type(2)));
DI unsigned pack2(float a, float b) { f2_t v = {a, b}; bf2_t r = __builtin_convertvector(v, bf2_t); return __builtin_bit_cast(unsigned, r); }
DI unsigned f2bf(float x) { return pack2(x, 0.f) & 0xffffu; }
DI float bflo(unsigned u) { return __uint_as_float(u << 16); }
DI float bfhi(unsigned u) { return __uint_as_float(u & 0xffff0000u); }
DI float bf2f(bf16_t s) { return __uint_as_float(((unsigned)s) << 16); }
DI int crow(int i, int h) { return (i & 3) + 8 * (i >> 2) + 4 * h; }
DI uint2 pack4(float a, float b, float c, float d) { uint2 r; r.x = pack2(a, b); r.y = pack2(c, d); return r; }
DI float fexp2(float x) { return __builtin_amdgcn_exp2f(x); }
DI float silu(float v) { return v / (1.f + __expf(-v)); }
DI bf16x8 pack8(const f32x16& x, int s8) {
  union { uint4 u; bf16x8 v; } r;
  r.u.x = pack2(x[s8 + 0], x[s8 + 1]); r.u.y = pack2(x[s8 + 2], x[s8 + 3]);
  r.u.z = pack2(x[s8 + 4], x[s8 + 5]); r.u.w = pack2(x[s8 + 6], x[s8 + 7]);
  return r.v;
}
DI bf16x8 ld2x8(const char* p) {
  union { uint4 u; bf16x8 v; } r;
  uint2 a = *(const uint2*)p, b = *(const uint2*)(p + 16);
  r.u.x = a.x; r.u.y = a.y; r.u.z = b.x; r.u.w = b.y;
  return r.v;
}

struct SrcRM { const bf16_t* base; int ld; DI const bf16_t* ptr(int row, int k0, int kc) const { return base + (size_t)row * ld + k0 + kc * 8; } };
struct SrcCmp { const bf16_t* base; DI const bf16_t* ptr(int row, int k0, int kc) const { int n = row > 126 ? 126 : row; return base + (size_t)(16 * n + (k0 >> 6)) * H0LD + kc * 8; } };

template <int PT, int QT> struct GemmRegs { u32x4 rp[2 * PT], rq[2 * QT]; };
template <int PT, int QT, class SP, class SQ>
DI void gemm_tile(char* smem, const SP& sp, int prow0, const SQ& sq, int qrow0, int K, f32x16 (&acc)[PT][QT],
                  GemmRegs<PT, QT>& R, const bool pre, const bool has_next, const SP& nsp, int nprow0, const SQ& nsq, int nqrow0) {
  constexpr int PB = 64 * PT * LDS_ROW, STG = 64 * (PT + QT) * LDS_ROW;
  const int tid = threadIdx.x, lane = tid & 63, w = __builtin_amdgcn_readfirstlane(tid >> 6), wp = w >> 1, wq = w & 1, r = lane & 31, h = lane >> 5;
  u32x4 (&rpA)[2 * PT] = R.rp; u32x4 (&rqA)[2 * QT] = R.rq;
#pragma unroll
  for (int ip = 0; ip < PT; ip++)
#pragma unroll
    for (int iq = 0; iq < QT; iq++)
#pragma unroll
      for (int i = 0; i < 16; i++) acc[ip][iq][i] = 0.f;
#define GT_GLOAD(RP, RQ, K0) { _Pragma("unroll") for (int i = 0; i < 2 * PT; i++) { int c = tid + 256 * i; RP[i] = *(const u32x4*)sp.ptr(prow0 + (c >> 3), (K0), c & 7); } \
    _Pragma("unroll") for (int i = 0; i < 2 * QT; i++) { int c = tid + 256 * i; RQ[i] = *(const u32x4*)sq.ptr(qrow0 + (c >> 3), (K0), c & 7); } }
#define GT_SSTORE(RP, RQ, ST) { char* st_ = (ST); _Pragma("unroll") for (int i = 0; i < 2 * PT; i++) { int c = tid + 256 * i; *(u32x4*)(st_ + (c >> 3) * LDS_ROW + (c & 7) * 16) = RP[i]; } \
    _Pragma("unroll") for (int i = 0; i < 2 * QT; i++) { int c = tid + 256 * i; *(u32x4*)(st_ + PB + (c >> 3) * LDS_ROW + (c & 7) * 16) = RQ[i]; } }
#define GT_COMPUTE(ST) { const char* sP = (ST); const char* sQ = sP + PB; __builtin_amdgcn_iglp_opt(0); \
    _Pragma("unroll") for (int s = 0; s < 4; s++) { bf16x8 a[PT], b[QT]; \
      _Pragma("unroll") for (int ip = 0; ip < PT; ip++) a[ip] = *(const bf16x8*)(sP + ((wp * PT + ip) * 32 + r) * LDS_ROW + s * 32 + h * 16); \
      _Pragma("unroll") for (int iq = 0; iq < QT; iq++) b[iq] = *(const bf16x8*)(sQ + ((wq * QT + iq) * 32 + r) * LDS_ROW + s * 32 + h * 16); \
      _Pragma("unroll") for (int ip = 0; ip < PT; ip++) _Pragma("unroll") for (int iq = 0; iq < QT; iq++) acc[ip][iq] = MFMA32(a[ip], b[iq], acc[ip][iq]); } }
  const int nk = K >> 6;
  if (!pre) GT_GLOAD(rpA, rqA, 0);
  GT_SSTORE(rpA, rqA, smem);
  if (nk > 1) GT_GLOAD(rpA, rqA, 64);
  for (int kt = 0; kt < nk; kt++) {
    __syncthreads();
    if (kt + 1 < nk) {
      GT_SSTORE(rpA, rqA, smem + ((kt + 1) & 1) * STG);
      if (kt + 2 < nk) GT_GLOAD(rpA, rqA, (kt + 2) * 64);
    }
    __builtin_amdgcn_sched_barrier(0);
    GT_COMPUTE(smem + (kt & 1) * STG);
  }
  if (has_next) {
#pragma unroll
    for (int i = 0; i < 2 * PT; i++) { int c = tid + 256 * i; rpA[i] = *(const u32x4*)nsp.ptr(nprow0 + (c >> 3), 0, c & 7); }
#pragma unroll
    for (int i = 0; i < 2 * QT; i++) { int c = tid + 256 * i; rqA[i] = *(const u32x4*)nsq.ptr(nqrow0 + (c >> 3), 0, c & 7); }
  }
  __syncthreads();
#undef GT_GLOAD
#undef GT_SSTORE
#undef GT_COMPUTE
}

template <int PT, int QT, class SP, class SQ>
DI void gemm_tile(char* smem, const SP& sp, int prow0, const SQ& sq, int qrow0, int K, f32x16 (&acc)[PT][QT]) {
  GemmRegs<PT, QT> R;
  gemm_tile<PT, QT>(smem, sp, prow0, sq, qrow0, K, acc, R, false, false, sp, prow0, sq, qrow0);
}

DI void epi_store_bf16(char* smem, const f32x16 (&acc)[2][2], bf16_t* dst, size_t ld, int valid) {
  const int tid = threadIdx.x, lane = tid & 63, w = __builtin_amdgcn_readfirstlane(tid >> 6), wp = w >> 1, wq = w & 1, r = lane & 31, h = lane >> 5;
#pragma unroll
  for (int ip = 0; ip < 2; ip++)
#pragma unroll
    for (int iq = 0; iq < 2; iq++)
#pragma unroll
      for (int gg = 0; gg < 4; gg++)
        *(uint2*)(smem + ((wq * 2 + iq) * 32 + r) * 272 + ((wp * 2 + ip) * 32 + 8 * gg + 4 * h) * 2) = pack4(acc[ip][iq][4 * gg], acc[ip][iq][4 * gg + 1], acc[ip][iq][4 * gg + 2], acc[ip][iq][4 * gg + 3]);
  __syncthreads();
#pragma unroll
  for (int i = 0; i < 8; i++) {
    int c = tid + 256 * i; int row = c >> 4, ch = c & 15;
    if (ch * 8 < valid) *(uint4*)(dst + (size_t)row * ld + ch * 8) = *(const uint4*)(smem + row * 272 + ch * 16);
  }
  __syncthreads();
}
DI void epi_store_bf16_ssq(char* smem, const f32x16 (&acc)[2][2], bf16_t* dst, size_t ld, int valid, float* ssq) {
  int tid_ = threadIdx.x; asm volatile("" : "+v"(tid_));
  const int tid = tid_, lane = tid & 63, w = __builtin_amdgcn_readfirstlane(tid >> 6), wp = w >> 1, wq = w & 1, r = lane & 31, h = lane >> 5;
#pragma unroll
  for (int ip = 0; ip < 2; ip++)
#pragma unroll
    for (int iq = 0; iq < 2; iq++)
#pragma unroll
      for (int gg = 0; gg < 4; gg++)
        *(uint2*)(smem + ((wq * 2 + iq) * 32 + r) * 272 + ((wp * 2 + ip) * 32 + 8 * gg + 4 * h) * 2) = pack4(acc[ip][iq][4 * gg], acc[ip][iq][4 * gg + 1], acc[ip][iq][4 * gg + 2], acc[ip][iq][4 * gg + 3]);
  __syncthreads();
#pragma unroll
  for (int i = 0; i < 8; i++) {
    int c = tid + 256 * i; int row = c >> 4, ch = c & 15;
    uint4 u = *(const uint4*)(smem + row * 272 + ch * 16);
    if (ch * 8 < valid) *(uint4*)(dst + (size_t)row * ld + ch * 8) = u;
    if (ssq) {
      float a0 = bflo(u.x), a1 = bfhi(u.x), a2 = bflo(u.y), a3 = bfhi(u.y), a4 = bflo(u.z), a5 = bfhi(u.z), a6 = bflo(u.w), a7 = bfhi(u.w);
      float s = a0 * a0 + a1 * a1 + a2 * a2 + a3 * a3 + a4 * a4 + a5 * a5 + a6 * a6 + a7 * a7;
      s += __shfl_xor(s, 8); s += __shfl_xor(s, 4); s += __shfl_xor(s, 2); s += __shfl_xor(s, 1);
      if (ch == 0) ssq[row] = s;
    }
  }
  __syncthreads();
}
DI void epi_store_f32_resid(char* smem, const f32x16 (&acc)[2][2], float* dst, const float* xres, size_t ld) {
  const int tid = threadIdx.x, lane = tid & 63, w = __builtin_amdgcn_readfirstlane(tid >> 6), wp = w >> 1, wq = w & 1, r = lane & 31, h = lane >> 5;
#pragma unroll
  for (int ip = 0; ip < 2; ip++)
#pragma unroll
    for (int iq = 0; iq < 2; iq++)
#pragma unroll
      for (int gg = 0; gg < 4; gg++) {
        float4 v; v.x = acc[ip][iq][4 * gg]; v.y = acc[ip][iq][4 * gg + 1]; v.z = acc[ip][iq][4 * gg + 2]; v.w = acc[ip][iq][4 * gg + 3];
        *(float4*)(smem + ((wq * 2 + iq) * 32 + r) * 528 + ((wp * 2 + ip) * 32 + 8 * gg + 4 * h) * 4) = v;
      }
  __syncthreads();
#pragma unroll
  for (int i = 0; i < 16; i++) {
    int c = tid + 256 * i; int row = c >> 5, ch = c & 31;
    float4 y = *(const float4*)(smem + row * 528 + ch * 16);
    float4 xv = *(const float4*)(xres + (size_t)row * ld + ch * 4);
    y.x += ALPHA * xv.x; y.y += ALPHA * xv.y; y.z += ALPHA * xv.z; y.w += ALPHA * xv.w;
    *(float4*)(dst + (size_t)row * ld + ch * 4) = y;
  }
  __syncthreads();
}

DI int map_h0(int n) {
  if (n < 1280) return n;
  if (n < 1792) return 1304 + (n - 1280);
  if (n < 2048) return 1816 + (n - 1792);
  if (n < 2304) return 2072 + (n - 2048);
  if (n < 2816) return 2328 + (n - 2304);
  if (n < 3328) return 2856 + (n - 2816);
  if (n < 3352) return 1280 + (n - 3328);
  if (n < 3360) return -1;
  if (n < 3376) return 2840 + (n - 3360);
  return -1;
}
DI int map_h1(int n) {
  if (n < 640) return n;
  if (n < 1664) return 672 + (n - 640);
  if (n < 1696) return 640 + (n - 1664);
  return -1;
}
DI int map_kv(int n) {
  if (n < 1024) return (n >> 6) * 128 + (n & 63);
  n -= 1024;
  return (n >> 6) * 128 + 64 + (n & 63);
}
DI void prep_tile(char* smem, bf16_t* dst, int K, const float* src, int ld, int mapid, const float* scale, int n0, int k0) {
  float* t = (float*)smem;
  const int tid = threadIdx.x;
  {
    int nl = tid & 63, kg = tid >> 6, n = n0 + nl;
    int sc = mapid == 0 ? n : mapid == 1 ? map_h0(n) : mapid == 2 ? map_h1(n) : map_kv(n);
#pragma unroll 4
    for (int i = 0; i < 16; i++) {
      int k = kg * 16 + i;
      float v = sc >= 0 ? src[(size_t)(k0 + k) * ld + sc] : 0.f;
      if (scale) v *= scale[k0 + k];
      t[k * 65 + nl] = v;
    }
  }
  __syncthreads();
  {
    int n = tid >> 2, kq = (tid & 3) * 16;
    uint4 a, b;
    a.x = pack2(t[(kq + 0) * 65 + n], t[(kq + 1) * 65 + n]); a.y = pack2(t[(kq + 2) * 65 + n], t[(kq + 3) * 65 + n]);
    a.z = pack2(t[(kq + 4) * 65 + n], t[(kq + 5) * 65 + n]); a.w = pack2(t[(kq + 6) * 65 + n], t[(kq + 7) * 65 + n]);
    b.x = pack2(t[(kq + 8) * 65 + n], t[(kq + 9) * 65 + n]); b.y = pack2(t[(kq + 10) * 65 + n], t[(kq + 11) * 65 + n]);
    b.z = pack2(t[(kq + 12) * 65 + n], t[(kq + 13) * 65 + n]); b.w = pack2(t[(kq + 14) * 65 + n], t[(kq + 15) * 65 + n]);
    bf16_t* d = dst + (size_t)(n0 + n) * K + k0 + kq;
    *(uint4*)d = a; *(uint4*)(d + 8) = b;
  }
  __syncthreads();
}
constexpr int P0_J0 = 54 * 16, P0_J1 = P0_J0 + 256, P0_J2 = P0_J1 + 28 * 16, P0_J3 = P0_J2 + 24 * 6, P0_J4 = P0_J3 + 32 * 4,
              P0_J5 = P0_J4 + 256, P0_J6 = P0_J5 + 2 * 2 * 32, P0_J7 = P0_J6 + 2 * 2, P0_J8 = P0_J7 + 16, P0_TOTAL = P0_J8 + 4096;
DI void p0_task(const Params& p, char* smem, int idx) {
  char* ws = p.ws;
  const int tid = threadIdx.x;
  if (idx < P0_J0) { prep_tile(smem, (bf16_t*)(ws + OFF_WT_IN0), 1024, p.e_w_in, 3368, 1, nullptr, (idx >> 4) * 64, (idx & 15) * 64); return; }
  if (idx < P0_J1) { int t = idx - P0_J0; prep_tile(smem, (bf16_t*)(ws + OFF_WT_OUT0), 1024, p.e_w_out, 1024, 0, nullptr, (t >> 4) * 64, (t & 15) * 64); return; }
  if (idx < P0_J2) { int t = idx - P0_J1; prep_tile(smem, (bf16_t*)(ws + OFF_WT_IN1), 1024, p.o_w_in, 1696, 2, nullptr, (t >> 4) * 64, (t & 15) * 64); return; }
  if (idx < P0_J3) { int t = idx - P0_J2; prep_tile(smem, (bf16_t*)(ws + OFF_WT_UQ), 384, p.o_w_uq, 1536, 0, p.o_q_norm, (t / 6) * 64, (t % 6) * 64); return; }
  if (idx < P0_J4) { int t = idx - P0_J3; prep_tile(smem, (bf16_t*)(ws + OFF_WT_UKV), 256, p.o_w_ukv, 2048, 3, p.o_kv_norm, (t >> 2) * 64, (t & 3) * 64); return; }
  if (idx < P0_J5) { int t = idx - P0_J4; prep_tile(smem, (bf16_t*)(ws + OFF_WT_OUT1), 1024, p.o_w_out, 1024, 0, nullptr, (t >> 4) * 64, (t & 15) * 64); return; }
  if (idx < P0_J6) { int t = idx - P0_J5; int j = t >> 6; t &= 63; prep_tile(smem, (bf16_t*)(ws + OFF_W1T) + (size_t)j * 128 * 2048, 2048, p.e_cmp_w1 + (size_t)j * 2048 * 128, 128, 0, nullptr, (t >> 5) * 64, (t & 31) * 64); return; }
  if (idx < P0_J7) { int t = idx - P0_J6; int j = t >> 1; prep_tile(smem, (bf16_t*)(ws + OFF_W2T) + (size_t)j * 64 * 128, 128, p.e_cmp_w2 + (size_t)j * 128 * 64, 64, 0, nullptr, 0, (t & 1) * 64); return; }
  if (idx < P0_J8) {
    int t = idx - P0_J7; int j = t >> 3, mg = t & 7;
    int m = mg * 16 + (tid & 15), ks = tid >> 4;
    const float* pe = p.e_cmp_pe + (size_t)j * 2048; const float* w1 = p.e_cmp_w1 + (size_t)j * 2048 * 128;
    float acc = 0.f;
    for (int kk = ks * 128; kk < ks * 128 + 128; kk++) acc += pe[kk] * w1[(size_t)kk * 128 + m];
    float* red = (float*)smem;
    red[tid] = acc;
    __syncthreads();
    if (tid < 16) { float s = 0.f; for (int q = 0; q < 16; q++) s += red[q * 16 + tid]; ((float*)(ws + OFF_BIAS1))[j * 128 + mg * 16 + tid] = s; }
    __syncthreads();
    return;
  }
  {
    int t = idx - P0_J8;
    float4 a[4], b[4];
#pragma unroll
    for (int q = 0; q < 4; q++) { size_t e = ((size_t)(t * 4 + q) * 256 + tid) * 8; a[q] = *(const float4*)(p.x + e); b[q] = *(const float4*)(p.x + e + 4); }
#pragma unroll
    for (int q = 0; q < 4; q++) {
      size_t e = ((size_t)(t * 4 + q) * 256 + tid) * 8;
      uint4 o; o.x = pack2(a[q].x, a[q].y); o.y = pack2(a[q].z, a[q].w); o.z = pack2(b[q].x, b[q].y); o.w = pack2(b[q].z, b[q].w);
      *(uint4*)((bf16_t*)(ws + OFF_REGD) + e) = o;
    }
  }
}

constexpr int P1_TOTAL = 256 * 27;
DI void p1_tile(const Params& p, char* smem, int tm, int tn, GemmRegs<2, 2>& gr, const bool pre, const bool has_next, int tm2, int tn2) {
  char* ws = p.ws;
  const int tid = threadIdx.x, lane = tid & 63, w = __builtin_amdgcn_readfirstlane(tid >> 6), wp = w >> 1, wq = w & 1, r = lane & 31, h = lane >> 5;
  SrcRM sx{(const bf16_t*)(ws + OFF_REGD), 1024}, sw{(const bf16_t*)(ws + OFF_WT_IN0), 1024};
  bf16_t* H0 = (bf16_t*)(ws + OFF_REGB);
  f32x16 acc[2][2];
  const int t0 = tm * 128, n0 = tn * 128;
  const bool tr = (tn == 7 || tn == 9 || (tn >= 18 && tn < 22));
  const bool tr2 = (tn2 == 7 || tn2 == 9 || (tn2 >= 18 && tn2 < 22));
  const int t02 = tm2 * 128, n02 = tn2 * 128;
  gemm_tile<2, 2>(smem, tr ? sx : sw, tr ? t0 : n0, tr ? sw : sx, tr ? n0 : t0, 1024, acc, gr, pre, has_next, tr2 ? sx : sw, tr2 ? t02 : n02, tr2 ? sw : sx, tr2 ? n02 : t02);
  if (!tr) {
    epi_store_bf16(smem, acc, H0 + (size_t)t0 * H0LD + n0, H0LD, H0LD - n0);
  } else {
    bf16_t* dst; int c0, NC;
    if (tn == 7) { dst = (bf16_t*)(ws + OFF_VTNSA); c0 = 0; NC = 256; }
    else if (tn == 9) { dst = (bf16_t*)(ws + OFF_VTNSA); c0 = 128; NC = 256; }
    else { dst = (bf16_t*)(ws + OFF_VTGLA); c0 = (tn - 18) * 128; NC = 512; }
    const int b = t0 >> 11, s0 = t0 & 2047;
    epi_store_bf16(smem, acc, dst + ((size_t)(b * NC + c0)) * 2048 + s0, 2048, 128);
  }
}

constexpr int P2_TOTAL = 128;
DI void p2_task(const Params& p, char* smem, int idx) {
  char* ws = p.ws;
  const int half = idx & 1, j = (idx >> 1) & 1, g = (idx >> 2) & 1, b = idx >> 3;
  const int tid = threadIdx.x, lane = tid & 63, w = __builtin_amdgcn_readfirstlane(tid >> 6), wp = w >> 1, wq = w & 1, r = lane & 31, h = lane >> 5;
  const bf16_t* H0 = (const bf16_t*)(ws + OFF_REGB);
  SrcCmp sa{H0 + (size_t)b * 2048 * H0LD + 512 + j * 128 + g * 64};
  SrcRM sw{(const bf16_t*)(ws + OFF_W1T) + (size_t)j * 128 * 2048, 2048};
  f32x16 acc[1][2];
  gemm_tile<1, 2>(smem, sa, half * 64, sw, 0, 2048, acc);
  const float* bias = (const float*)(ws + OFF_BIAS1) + j * 128;
  char* sH = smem; char* sW = smem + 64 * 272;
#pragma unroll
  for (int iq = 0; iq < 2; iq++) {
    int m = (wq * 2 + iq) * 32 + r; float bm = bias[m];
#pragma unroll
    for (int i = 0; i < 16; i++) {
      int nl = wp * 32 + crow(i, h);
      ((bf16_t*)(sH + nl * 272))[m] = (bf16_t)f2bf(silu(acc[0][iq][i] + bm));
    }
  }
  const bf16_t* W2T = (const bf16_t*)(ws + OFF_W2T) + (size_t)j * 64 * 128;
#pragma unroll
  for (int i = 0; i < 4; i++) { int c = tid + 256 * i; int row = c >> 4, kc = c & 15; *(uint4*)(sW + row * 272 + kc * 16) = *(const uint4*)(W2T + row * 128 + kc * 8); }
  __syncthreads();
  f32x16 o;
#pragma unroll
  for (int i = 0; i < 16; i++) o[i] = 0.f;
  if (j == 0) {
#pragma unroll
    for (int s = 0; s < 8; s++) {
      bf16x8 a = *(const bf16x8*)(sW + (wp * 32 + r) * 272 + s * 32 + h * 16);
      bf16x8 bq = *(const bf16x8*)(sH + (wq * 32 + r) * 272 + s * 32 + h * 16);
      o = MFMA32(a, bq, o);
    }
    bf16_t* KC = (bf16_t*)(ws + OFF_KCMP);
    int n = half * 64 + wq * 32 + r;
#pragma unroll
    for (int gg = 0; gg < 4; gg++)
      *(uint2*)(KC + ((size_t)((b * 2 + g) * 128 + n)) * 64 + wp * 32 + 8 * gg + 4 * h) = pack4(o[4 * gg], o[4 * gg + 1], o[4 * gg + 2], o[4 * gg + 3]);
  } else {
#pragma unroll
    for (int s = 0; s < 8; s++) {
      bf16x8 a = *(const bf16x8*)(sH + (wp * 32 + r) * 272 + s * 32 + h * 16);
      bf16x8 bq = *(const bf16x8*)(sW + (wq * 32 + r) * 272 + s * 32 + h * 16);
      o = MFMA32(a, bq, o);
    }
    bf16_t* VC = (bf16_t*)(ws + OFF_VCMPT);
    int d = wq * 32 + r;
#pragma unroll
    for (int gg = 0; gg < 4; gg++)
      *(uint2*)(VC + ((size_t)((b * 2 + g) * 64 + d)) * 128 + half * 64 + wp * 32 + 8 * gg + 4 * h) = pack4(o[4 * gg], o[4 * gg + 1], o[4 * gg + 2], o[4 * gg + 3]);
  }
  __syncthreads();
}

template <int DQK, bool ALIBI, class KP, class VP, class NM, class VIS>
DI void attn_loop(const int tid, char* smem, const bf16x8 (&qf)[DQK / 16], int jlo, int jhi, unsigned tmask, int wave_jhi, KP kp, VP vp,
                  const float c1, const float slope2, const int tq, NM needmask, VIS vis, f32x16 (&o)[2], float& m, float& l) {
  constexpr int KROW = DQK * 2 + 16, KSZ = 64 * KROW, VROW = 136  , STG = KSZ + 64 * VROW, KCH = DQK / 8, NKC = KCH / 4;
  const int lane = tid & 63, r = lane & 31, h = lane >> 5;
  u32x4 rk[NKC], rv[2];
  auto nexttile = [&](int from) { while (from <= jhi && !((tmask >> from) & 1u)) from++; return from <= jhi ? from : -1; };
#define ATT_GLOAD(JT) { _Pragma("unroll") for (int i = 0; i < NKC; i++) { int c = tid + 256 * i; int row = c / KCH, kc = c % KCH; rk[i] = *(const u32x4*)kp((JT) * 64 + row, kc); } \
    _Pragma("unroll") for (int i = 0; i < 2; i++) { int c = tid + 256 * i; int row = c >> 3, kc = c & 7; rv[i] = *(const u32x4*)vp(row, (JT) * 64 + kc * 8); } }
#define ATT_SSTORE(ST) { char* st_ = (ST); _Pragma("unroll") for (int i = 0; i < NKC; i++) { int c = tid + 256 * i; int row = c / KCH, kc = c % KCH; *(u32x4*)(st_ + row * KROW + kc * 16) = rk[i]; } \
    _Pragma("unroll") for (int i = 0; i < 2; i++) { int c = tid + 256 * i; int row = c >> 3, kc = c & 7; uint2 lo_, hi_; lo_.x = rv[i].x; lo_.y = rv[i].y; hi_.x = rv[i].z; hi_.y = rv[i].w; \
      *(uint2*)(st_ + KSZ + row * VROW + kc * 16) = lo_; *(uint2*)(st_ + KSZ + row * VROW + kc * 16 + 8) = hi_; } }
  int jt = nexttile(jlo);
  if (jt < 0) return;
  ATT_GLOAD(jt); ATT_SSTORE(smem);
  int jn = nexttile(jt + 1);
  if (jn >= 0) ATT_GLOAD(jn);
  int stg = 0;
  while (true) {
    __syncthreads();
    int jnn = -1;
    if (jn >= 0) { ATT_SSTORE(smem + (stg ^ 1) * STG); jnn = nexttile(jn + 1); if (jnn >= 0) ATT_GLOAD(jnn); }
    __builtin_amdgcn_sched_barrier(0);
    if (jt <= wave_jhi) {
      const char* sK = smem + stg * STG; const char* sV = sK + KSZ;
      f32x16 st[2];
#pragma unroll
      for (int kt = 0; kt < 2; kt++)
#pragma unroll
        for (int i = 0; i < 16; i++) st[kt][i] = 0.f;
#pragma unroll
      for (int s = 0; s < DQK / 16; s++)
#pragma unroll
        for (int kt = 0; kt < 2; kt++) {
          bf16x8 a = *(const bf16x8*)(sK + (32 * kt + r) * KROW + s * 32 + h * 16);
          st[kt] = MFMA32(a, qf[s], st[kt]);
        }
      const bool nmask = needmask(jt);
      float mx = -INFINITY, muse, mnew;
      if (ALIBI) {
        const float tb = slope2 * (float)(jt * 64 + 4 * h - tq);
#pragma unroll
        for (int kt = 0; kt < 2; kt++)
#pragma unroll
          for (int i = 0; i < 16; i++) st[kt][i] = fmaf(st[kt][i], c1, fmaf(slope2, (float)(32 * kt + (i & 3) + 8 * (i >> 2)), tb));
      }
      if (nmask) {
#pragma unroll
        for (int kt = 0; kt < 2; kt++)
#pragma unroll
          for (int i = 0; i < 16; i++) st[kt][i] = vis(jt * 64 + 32 * kt + crow(i, h), jt) ? st[kt][i] : -INFINITY;
      }
#pragma unroll
      for (int kt = 0; kt < 2; kt++)
#pragma unroll
        for (int i = 0; i < 16; i++) mx = fmaxf(mx, st[kt][i]);
      if (!ALIBI) mx *= c1;
      mx = fmaxf(mx, __shfl_xor(mx, 32));
      mnew = fmaxf(m, mx);
      if (__builtin_amdgcn_ballot_w64(mnew > m + 8.f) != 0) {
        float alpha = (mnew == m) ? 1.f : fexp2(m - mnew);
        l *= alpha;
#pragma unroll
        for (int dt = 0; dt < 2; dt++)
#pragma unroll
          for (int i = 0; i < 16; i++) o[dt][i] *= alpha;
        m = mnew;
      }
      muse = (m == -INFINITY) ? 0.f : m;
      float ps = 0.f;
      const float nm = -muse;
#pragma unroll
      for (int kt = 0; kt < 2; kt++)
#pragma unroll
        for (int i = 0; i < 16; i++) { float pv = ALIBI ? fexp2(st[kt][i] + nm) : fexp2(fmaf(st[kt][i], c1, nm)); st[kt][i] = pv; ps += pv; }
      l += ps;
#pragma unroll
      for (int kt = 0; kt < 2; kt++)
#pragma unroll
        for (int s2 = 0; s2 < 2; s2++) {
          bf16x8 pf = pack8(st[kt], 8 * s2);
#pragma unroll
          for (int dt = 0; dt < 2; dt++) {
            bf16x8 vf = ld2x8(sV + (32 * dt + r) * VROW + (32 * kt + 16 * s2 + 4 * h) * 2);
            o[dt] = MFMA32(vf, pf, o[dt]);
          }
        }
    }
    if (jn < 0) break;
    jt = jn; jn = jnn; stg ^= 1;
  }
  __syncthreads();
}

constexpr int NSA_TASKS = 16 * 2 * 64;
DI void nsa_task(const Params& p, char* smem, int idx) {
  char* ws = p.ws;
  const int qb = 63 - (idx >> 5), g = idx & 1, b = (idx >> 1) & 15;
  int tid_ = threadIdx.x; asm volatile("" : "+v"(tid_));
  const int tid = tid_, lane = tid & 63, w = __builtin_amdgcn_readfirstlane(tid >> 6), r = lane & 31, h = lane >> 5;
  const int hq = g * 4 + w;
  const float slope2 = exp2f(-(float)(hq + 1)) * LOG2E;
  const float c1 = 0.125f * LOG2E;
  const int t = qb * 32 + r;
  const size_t tok = (size_t)b * 2048 + t;
  const bf16_t* H0 = (const bf16_t*)(ws + OFF_REGB);
  bf16x8 qf[4];
#pragma unroll
  for (int s = 0; s < 4; s++) qf[s] = *(const bf16x8*)(H0 + tok * H0LD + hq * 64 + 16 * s + 8 * h);
  float gate[3];
#pragma unroll
  for (int br = 0; br < 3; br++) { float gl = bf2f(H0[tok * H0LD + 3328 + br * 8 + hq]); gate[br] = 1.f / (1.f + __expf(-gl)); }
  f32x16 tot[2];
  float* impw = (float*)(smem + 36864);
  unsigned* selmask = (unsigned*)(smem + 36864 + 16896);
  unsigned* umaskp = selmask + 32;
  const int cur = qb >> 1;
  {
    const bf16_t* KC = (const bf16_t*)(ws + OFF_KCMP) + (size_t)(b * 2 + g) * 128 * 64;
    const bf16_t* VC = (const bf16_t*)(ws + OFF_VCMPT) + (size_t)(b * 2 + g) * 64 * 128;
    char* sK = smem; char* sV = smem + 18432;
#pragma unroll
    for (int i = 0; i < 4; i++) { int c = tid + 256 * i; int row = c >> 3, kc = c & 7; *(uint4*)(sK + row * LDS_ROW + kc * 16) = *(const uint4*)(KC + row * 64 + kc * 8); }
#pragma unroll
    for (int i = 0; i < 4; i++) { int c = tid + 256 * i; int row = c >> 4, kc = c & 15; *(uint4*)(sV + row * 272 + kc * 16) = *(const uint4*)(VC + row * 128 + kc * 8); }
    if (tid < 32) selmask[tid] = 0u;
    if (tid == 32) *umaskp = 0u;
    __syncthreads();
    f32x16 st[4];
#pragma unroll
    for (int kt = 0; kt < 4; kt++)
#pragma unroll
      for (int i = 0; i < 16; i++) st[kt][i] = 0.f;
#pragma unroll
    for (int s = 0; s < 4; s++)
#pragma unroll
      for (int kt = 0; kt < 4; kt++) {
        bf16x8 a = *(const bf16x8*)(sK + (32 * kt + r) * LDS_ROW + s * 32 + h * 16);
        st[kt] = MFMA32(a, qf[s], st[kt]);
      }
    float mx = -INFINITY;
#pragma unroll
    for (int kt = 0; kt < 4; kt++)
#pragma unroll
      for (int i = 0; i < 16; i++) {
        int n = 32 * kt + crow(i, h);
        int dist = t - (16 * n + 31);
        float v = (dist >= 0 && n < 127) ? st[kt][i] * c1 - slope2 * (float)dist : -INFINITY;
        st[kt][i] = v; mx = fmaxf(mx, v);
      }
    mx = fmaxf(mx, __shfl_xor(mx, 32));
    float muse = (mx == -INFINITY) ? 0.f : mx;
    float ps = 0.f;
#pragma unroll
    for (int kt = 0; kt < 4; kt++)
#pragma unroll
      for (int i = 0; i < 16; i++) { float pv = fexp2(st[kt][i] - muse); st[kt][i] = pv; ps += pv; }
    ps += __shfl_xor(ps, 32);
    float inv = ps > 0.f ? 1.f / ps : 0.f;
#pragma unroll
    for (int kt = 0; kt < 4; kt++)
#pragma unroll
      for (int i = 0; i < 16; i++) st[kt][i] *= inv;
    {
      float prev = 0.f;
#pragma unroll
      for (int f = 0; f < 16; f++) {
        const int kt = f >> 2, gg = f & 3;
        float p3 = 0.5f * st[kt][4 * gg + 3];
        float mainv = st[kt][4 * gg] + st[kt][4 * gg + 1] + st[kt][4 * gg + 2] + p3;
        float rc = __shfl_xor(p3, 32);
        mainv += (h == 1) ? rc : prev;
        prev = rc;
        impw[(w * 32 + r) * 33 + 2 * f + h] = mainv;
      }
    }
#pragma unroll
    for (int dt = 0; dt < 2; dt++)
#pragma unroll
      for (int i = 0; i < 16; i++) tot[dt][i] = 0.f;
#pragma unroll
    for (int kt = 0; kt < 4; kt++)
#pragma unroll
      for (int s2 = 0; s2 < 2; s2++) {
        bf16x8 pf = pack8(st[kt], 8 * s2);
#pragma unroll
        for (int dt = 0; dt < 2; dt++) {
          bf16x8 vf = ld2x8(sV + (32 * dt + r) * 272 + (32 * kt + 16 * s2 + 4 * h) * 2);
          tot[dt] = MFMA32(vf, pf, tot[dt]);
        }
      }
#pragma unroll
    for (int dt = 0; dt < 2; dt++)
#pragma unroll
      for (int i = 0; i < 16; i++) tot[dt][i] *= gate[0];
    __syncthreads();
    {
      int q = tid >> 3, jq = tid & 7;
#pragma unroll
      for (int e = 0; e < 4; e++) {
        int j = jq * 4 + e;
        float s = impw[(0 * 32 + q) * 33 + j] + impw[(1 * 32 + q) * 33 + j] + impw[(2 * 32 + q) * 33 + j] + impw[(3 * 32 + q) * 33 + j];
        impw[q * 33 + j] = s;
      }
    }
    __syncthreads();
    {
      int q = tid >> 3, jq = tid & 7;
      int nforced = cur == 0 ? 1 : (cur == 1 ? 2 : 3);
      unsigned bits = 0u;
#pragma unroll
      for (int e = 0; e < 4; e++) {
        int j = jq * 4 + e;
        if (j > cur) continue;
        bool forced = (j == 0) || (j == cur) || (j == cur - 1);
        if (forced) { bits |= 1u << j; continue; }
        float v = impw[q * 33 + j];
        int rank = 0;
        for (int j2 = 1; j2 < cur - 1; j2++) {
          float v2 = impw[q * 33 + j2];
          rank += (v2 > v || (v2 == v && j2 < j)) ? 1 : 0;
        }
        if (nforced + rank < 8) bits |= 1u << j;
      }
      if (bits) { atomicOr(&selmask[q], bits); atomicOr(umaskp, bits); }
    }
    __syncthreads();
  }
  const unsigned mysel = selmask[r];
  const unsigned umask = *umaskp;
  unsigned allsel_v = mysel;
#pragma unroll
  for (int off = 16; off >= 1; off >>= 1) allsel_v &= (unsigned)__shfl_xor((int)allsel_v, off);
  const unsigned allsel = __builtin_amdgcn_readfirstlane(allsel_v);
  __syncthreads();
  {
    f32x16 o[2];
#pragma unroll
    for (int dt = 0; dt < 2; dt++)
#pragma unroll
      for (int i = 0; i < 16; i++) o[dt][i] = 0.f;
    float m = -INFINITY, l = 0.f;
    const bf16_t* Kb = H0 + (size_t)b * 2048 * H0LD + 768 + g * 64;
    const bf16_t* Vb = (const bf16_t*)(ws + OFF_VTNSA) + ((size_t)(b * 256 + g * 64)) * 2048;
    attn_loop<64, true>(tid, smem, qf, 0, cur, umask, cur,
                  [&](int key, int kc) { return Kb + (size_t)key * H0LD + kc * 8; },
                  [&](int row, int key) { return Vb + (size_t)row * 2048 + key; },
                  c1, slope2, t,
                  [&](int jt) { return !((allsel >> jt) & 1u) || (jt * 64 + 63 > qb * 32); },
                  [&](int key, int jt) { return ((mysel >> jt) & 1u) && key <= t; },
                  o, m, l);
    l += __shfl_xor(l, 32);
    float sc = l > 0.f ? gate[1] / l : 0.f;
#pragma unroll
    for (int dt = 0; dt < 2; dt++)
#pragma unroll
      for (int i = 0; i < 16; i++) tot[dt][i] += sc * o[dt][i];
  }
  {
    f32x16 o[2];
#pragma unroll
    for (int dt = 0; dt < 2; dt++)
#pragma unroll
      for (int i = 0; i < 16; i++) o[dt][i] = 0.f;
    float m = -INFINITY, l = 0.f;
    const bf16_t* Kb = H0 + (size_t)b * 2048 * H0LD + 1024 + g * 64;
    const bf16_t* Vb = (const bf16_t*)(ws + OFF_VTNSA) + ((size_t)(b * 256 + 128 + g * 64)) * 2048;
    int lo = qb * 32 - 511; lo = lo < 0 ? 0 : (lo >> 6);
    attn_loop<64, true>(tid, smem, qf, lo, cur, 0xffffffffu, cur,
                  [&](int key, int kc) { return Kb + (size_t)key * H0LD + kc * 8; },
                  [&](int row, int key) { return Vb + (size_t)row * 2048 + key; },
                  c1, slope2, t,
                  [&](int jt) { return (qb * 32 + 31 - 64 * jt > 511) || (qb * 32 - 64 * jt - 63 < 0); },
                  [&](int key, int jt) { int dist = t - key; return dist >= 0 && dist < 512; },
                  o, m, l);
    l += __shfl_xor(l, 32);
    float sc = l > 0.f ? gate[2] / l : 0.f;
#pragma unroll
    for (int dt = 0; dt < 2; dt++)
#pragma unroll
      for (int i = 0; i < 16; i++) tot[dt][i] += sc * o[dt][i];
  }
  bf16_t* CAT = (bf16_t*)(ws + OFF_REGD);
#pragma unroll
  for (int dt = 0; dt < 2; dt++)
#pragma unroll
    for (int gg = 0; gg < 4; gg++) {
      int dv = 32 * dt + 8 * gg + 4 * h;
      uint2 z = *(const uint2*)(H0 + tok * H0LD + 1280 + hq * 64 + dv);
      *(uint2*)(CAT + tok * 1024 + hq * 64 + dv) =
          pack4(tot[dt][4 * gg] * silu(bflo(z.x)), tot[dt][4 * gg + 1] * silu(bfhi(z.x)), tot[dt][4 * gg + 2] * silu(bflo(z.y)), tot[dt][4 * gg + 3] * silu(bfhi(z.y)));
    }
}

constexpr int GLA_CHUNK_TASKS = 2048;
DI void gla_a_task(const Params& p, char* smem, int idx) {
  char* ws = p.ws;
  const int chunk = idx & 31, hh = (idx >> 5) & 3, b = idx >> 7;
  int tid_ = threadIdx.x; asm volatile("" : "+v"(tid_));
  const int tid = tid_, lane = tid & 63, w = __builtin_amdgcn_readfirstlane(tid >> 6), r = lane & 31, h = lane >> 5;
  const bf16_t* H0 = (const bf16_t*)(ws + OFF_REGB);
  const bf16_t* VT = (const bf16_t*)(ws + OFF_VTGLA) + ((size_t)(b * 512 + hh * 128)) * 2048;
  char* sQ = smem; char* sK = smem + 9216; char* sKKT = smem + 18432; char* sVT = smem + 27648;
  float* sTot = (float*)(smem + 46080); float* sB = (float*)(smem + 46080 + 1280);
  const int d = tid & 63, cq = w;
  const size_t tok0 = (size_t)b * 2048 + chunk * 64;
  uint4 vreg[4];
#pragma unroll
  for (int i = 0; i < 4; i++) { int c = tid + 256 * i; int row = c >> 3, kc = c & 7; vreg[i] = *(const uint4*)(VT + (size_t)row * 2048 + chunk * 64 + kc * 8); }
  float wg[16];
#pragma unroll
  for (int q = 0; q < 16; q++) wg[q] = p.e_gla_w_gate[q * 256 + hh * 64 + d];
  const float bg = p.e_gla_b_gate[hh * 64 + d];
  float cum[16]; float run = 0.f;
#pragma unroll
  for (int i = 0; i < 16; i++) {
    const bf16_t* gl = H0 + (tok0 + cq * 16 + i) * H0LD + 3360;
    uint4 g0 = *(const uint4*)gl, g1 = *(const uint4*)(gl + 8);
    float a = bg;
    a += bflo(g0.x) * wg[0] + bfhi(g0.x) * wg[1] + bflo(g0.y) * wg[2] + bfhi(g0.y) * wg[3];
    a += bflo(g0.z) * wg[4] + bfhi(g0.z) * wg[5] + bflo(g0.w) * wg[6] + bfhi(g0.w) * wg[7];
    a += bflo(g1.x) * wg[8] + bfhi(g1.x) * wg[9] + bflo(g1.y) * wg[10] + bfhi(g1.y) * wg[11];
    a += bflo(g1.z) * wg[12] + bfhi(g1.z) * wg[13] + bflo(g1.w) * wg[14] + bfhi(g1.w) * wg[15];
    float ls = fminf(a, 0.f) - __logf(1.f + __expf(-fabsf(a)));
    run += ls * (1.f / 16.f);
    cum[i] = run;
  }
  sTot[cq * 64 + d] = run;
  bf16_t qraw[16], kraw[16];
#pragma unroll
  for (int i = 0; i < 16; i++) { size_t tk = tok0 + cq * 16 + i; qraw[i] = H0[tk * H0LD + 1792 + hh * 64 + d]; kraw[i] = H0[tk * H0LD + 2048 + hh * 64 + d]; }
#pragma unroll
  for (int i = 0; i < 4; i++) { int c = tid + 256 * i; int row = c >> 3, kc = c & 7; *(uint4*)(sVT + row * LDS_ROW + kc * 16) = vreg[i]; }
  __syncthreads();
  {
    float t0 = sTot[d], t1 = sTot[64 + d], t2 = sTot[128 + d], t3 = sTot[192 + d];
    float off = cq == 0 ? 0.f : cq == 1 ? t0 : cq == 2 ? t0 + t1 : t0 + t1 + t2;
    float blast = t0 + t1 + t2 + t3;
    bf16_t* QD = (bf16_t*)(ws + OFF_QD);
#pragma unroll
    for (int i = 0; i < 16; i++) {
      int c = cq * 16 + i;
      float bb = cum[i] + off;
      float qv = bf2f(qraw[i]), kv = bf2f(kraw[i]);
      bf16_t qd = (bf16_t)f2bf(qv * 0.125f * __expf(bb));
      ((bf16_t*)(sQ + c * LDS_ROW))[d] = qd;
      QD[(tok0 + c) * 256 + hh * 64 + d] = qd;
      ((bf16_t*)(sK + c * LDS_ROW))[d] = (bf16_t)f2bf(kv * __expf(-bb));
      ((bf16_t*)(sKKT + d * LDS_ROW))[c] = (bf16_t)f2bf(kv * __expf(blast - bb));
    }
    if (cq == 0) ((float*)(ws + OFF_DEC))[(size_t)idx * 64 + d] = __expf(blast);
  }
  __syncthreads();
  f32x16 at0, at1, at2;
#pragma unroll
  for (int i = 0; i < 16; i++) { at0[i] = 0.f; at1[i] = 0.f; at2[i] = 0.f; }
#pragma unroll
  for (int s = 0; s < 4; s++) {
    bf16x8 k0 = *(const bf16x8*)(sK + (r)*LDS_ROW + s * 32 + h * 16);
    bf16x8 k1 = *(const bf16x8*)(sK + (32 + r) * LDS_ROW + s * 32 + h * 16);
    bf16x8 q0 = *(const bf16x8*)(sQ + (r)*LDS_ROW + s * 32 + h * 16);
    bf16x8 q1 = *(const bf16x8*)(sQ + (32 + r) * LDS_ROW + s * 32 + h * 16);
    at0 = MFMA32(k0, q0, at0); at1 = MFMA32(k0, q1, at1); at2 = MFMA32(k1, q1, at2);
  }
#pragma unroll
  for (int i = 0; i < 16; i++) { if (r < crow(i, h)) { at0[i] = 0.f; at2[i] = 0.f; } }
  f32x16 o[2], U[2];
#pragma unroll
  for (int c2 = 0; c2 < 2; c2++)
#pragma unroll
    for (int i = 0; i < 16; i++) { o[c2][i] = 0.f; U[c2][i] = 0.f; }
#pragma unroll
  for (int s2 = 0; s2 < 2; s2++) {
    bf16x8 v0 = ld2x8(sVT + (32 * w + r) * LDS_ROW + (0 + 16 * s2 + 4 * h) * 2);
    bf16x8 v1 = ld2x8(sVT + (32 * w + r) * LDS_ROW + (32 + 16 * s2 + 4 * h) * 2);
    o[0] = MFMA32(pack8(at0, 8 * s2), v0, o[0]);
    o[1] = MFMA32(pack8(at1, 8 * s2), v0, o[1]);
    o[1] = MFMA32(pack8(at2, 8 * s2), v1, o[1]);
  }
#pragma unroll
  for (int dT = 0; dT < 2; dT++)
#pragma unroll
    for (int s4 = 0; s4 < 4; s4++) {
      bf16x8 a = *(const bf16x8*)(sKKT + (32 * dT + r) * LDS_ROW + s4 * 32 + h * 16);
      bf16x8 bq = *(const bf16x8*)(sVT + (32 * w + r) * LDS_ROW + s4 * 32 + h * 16);
      U[dT] = MFMA32(a, bq, U[dT]);
    }
  bf16_t* OI = (bf16_t*)(ws + OFF_OI);
  const int dv = 32 * w + r;
#pragma unroll
  for (int c2 = 0; c2 < 2; c2++)
#pragma unroll
    for (int i = 0; i < 16; i++) OI[(tok0 + 32 * c2 + crow(i, h)) * 512 + hh * 128 + dv] = (bf16_t)f2bf(o[c2][i]);
  float* UPD = (float*)(ws + OFF_UPD) + ((size_t)idx * 128 + dv) * 64;
#pragma unroll
  for (int dT = 0; dT < 2; dT++)
#pragma unroll
    for (int gg = 0; gg < 4; gg++) {
      float4 u; u.x = U[dT][4 * gg]; u.y = U[dT][4 * gg + 1]; u.z = U[dT][4 * gg + 2]; u.w = U[dT][4 * gg + 3];
      *(float4*)(UPD + 32 * dT + 8 * gg + 4 * h) = u;
    }
  __syncthreads();
}

constexpr int GLA_B_TASKS = 512;
DI void gla_b_task(const Params& p, int idx) {
  char* ws = p.ws;
  const int gid = idx * 256 + threadIdx.x;
  const int bh = gid >> 11, dv = (gid >> 4) & 127, dq = gid & 15;
  const float* UPD = (const float*)(ws + OFF_UPD) + ((size_t)bh * 32 * 128 + dv) * 64 + dq * 4;
  const float* DEC = (const float*)(ws + OFF_DEC) + (size_t)bh * 32 * 64 + dq * 4;
  bf16_t* ST = (bf16_t*)(ws + OFF_ST) + ((size_t)bh * 32 * 128 + dv) * 64 + dq * 4;
  float4 s = {0.f, 0.f, 0.f, 0.f};
#pragma unroll 1
  for (int n0 = 0; n0 < 32; n0 += 8) {
    float4 u[8], dc[8];
#pragma unroll
    for (int q = 0; q < 8; q++) { u[q] = *(const float4*)(UPD + (size_t)(n0 + q) * 128 * 64); dc[q] = *(const float4*)(DEC + (n0 + q) * 64); }
#pragma unroll
    for (int q = 0; q < 8; q++) {
      *(uint2*)(ST + (size_t)(n0 + q) * 128 * 64) = pack4(s.x, s.y, s.z, s.w);
      s.x = dc[q].x * s.x + u[q].x; s.y = dc[q].y * s.y + u[q].y; s.z = dc[q].z * s.z + u[q].z; s.w = dc[q].w * s.w + u[q].w;
    }
  }
}

DI void gla_c_task(const Params& p, char* smem, int idx) {
  char* ws = p.ws;
  const int chunk = idx & 31, hh = (idx >> 5) & 3, b = idx >> 7;
  int tid_ = threadIdx.x; asm volatile("" : "+v"(tid_));
  const int tid = tid_, lane = tid & 63, w = __builtin_amdgcn_readfirstlane(tid >> 6), r = lane & 31, h = lane >> 5;
  const bf16_t* H0 = (const bf16_t*)(ws + OFF_REGB);
  const bf16_t* QD = (const bf16_t*)(ws + OFF_QD);
  const bf16_t* ST = (const bf16_t*)(ws + OFF_ST) + (size_t)idx * 128 * 64;
  const bf16_t* OI = (const bf16_t*)(ws + OFF_OI);
  bf16_t* CAT = (bf16_t*)(ws + OFF_REGD);
  char* sQ = smem; char* sS = smem + 9216; float* sO = (float*)(smem + 27648);
  const size_t tok0 = (size_t)b * 2048 + chunk * 64;
#pragma unroll
  for (int i = 0; i < 2; i++) { int c = tid + 256 * i; int row = c >> 3, kc = c & 7; *(uint4*)(sQ + row * LDS_ROW + kc * 16) = *(const uint4*)(QD + (tok0 + row) * 256 + hh * 64 + kc * 8); }
#pragma unroll
  for (int i = 0; i < 4; i++) { int c = tid + 256 * i; int row = c >> 3, kc = c & 7; *(uint4*)(sS + row * LDS_ROW + kc * 16) = *(const uint4*)(ST + row * 64 + kc * 8); }
  const int dv = 32 * w + r;
  float oi[2][16];
#pragma unroll
  for (int c2 = 0; c2 < 2; c2++)
#pragma unroll
    for (int i = 0; i < 16; i++) oi[c2][i] = bf2f(OI[(tok0 + 32 * c2 + crow(i, h)) * 512 + hh * 128 + dv]);
  __syncthreads();
  f32x16 o[2];
#pragma unroll
  for (int c2 = 0; c2 < 2; c2++)
#pragma unroll
    for (int i = 0; i < 16; i++) o[c2][i] = oi[c2][i];
#pragma unroll
  for (int s = 0; s < 4; s++) {
    bf16x8 bq = *(const bf16x8*)(sS + (32 * w + r) * LDS_ROW + s * 32 + h * 16);
#pragma unroll
    for (int c2 = 0; c2 < 2; c2++) {
      bf16x8 a = *(const bf16x8*)(sQ + (32 * c2 + r) * LDS_ROW + s * 32 + h * 16);
      o[c2] = MFMA32(a, bq, o[c2]);
    }
  }
#pragma unroll
  for (int c2 = 0; c2 < 2; c2++)
#pragma unroll
    for (int i = 0; i < 16; i++) sO[(32 * c2 + crow(i, h)) * 129 + dv] = o[c2][i];
  __syncthreads();
  {
    int c = tid >> 2, part = tid & 3; size_t tk = tok0 + c;
    float ssq = 0.f;
#pragma unroll
    for (int i4 = 0; i4 < 4; i4++)
#pragma unroll
      for (int e = 0; e < 8; e++) { float v = sO[c * 129 + (i4 * 4 + part) * 8 + e]; ssq += v * v; }
    ssq += __shfl_xor(ssq, 1); ssq += __shfl_xor(ssq, 2);
    float rinv = rsqrtf(ssq * (1.f / 128.f) + EPS);
#pragma unroll
    for (int i4 = 0; i4 < 4; i4++) {
      int dv0 = (i4 * 4 + part) * 8;
      uint4 z = *(const uint4*)(H0 + tk * H0LD + 2816 + hh * 128 + dv0);
      const float* ng = p.e_gla_norm + dv0; const float* so = sO + c * 129 + dv0;
      uint4 ov;
      ov.x = pack2(so[0] * rinv * ng[0] * silu(bflo(z.x)), so[1] * rinv * ng[1] * silu(bfhi(z.x)));
      ov.y = pack2(so[2] * rinv * ng[2] * silu(bflo(z.y)), so[3] * rinv * ng[3] * silu(bfhi(z.y)));
      ov.z = pack2(so[4] * rinv * ng[4] * silu(bflo(z.z)), so[5] * rinv * ng[5] * silu(bfhi(z.z)));
      ov.w = pack2(so[6] * rinv * ng[6] * silu(bflo(z.w)), so[7] * rinv * ng[7] * silu(bfhi(z.w)));
      *(uint4*)(CAT + tk * 1024 + 512 + hh * 128 + dv0) = ov;
    }
  }
  __syncthreads();
}

constexpr int OP_TILES = 256 * 8;
DI void outproj_tile(const Params& p, char* smem, int tm, int tn, int layer, GemmRegs<2, 2>& gr, const bool pre, const bool has_next, int tm2, int tn2) {
  char* ws = p.ws;
  const int tid = threadIdx.x, lane = tid & 63, w = __builtin_amdgcn_readfirstlane(tid >> 6), wp = w >> 1, wq = w & 1, r = lane & 31, h = lane >> 5;
  const int t0 = tm * 128, n0 = tn * 128;
  SrcRM sc{(const bf16_t*)(ws + OFF_REGD), 1024}, sw{(const bf16_t*)(ws + (layer ? OFF_WT_OUT1 : OFF_WT_OUT0)), 1024};
  const float* xres = layer ? p.out : p.x;
  float* Y = (float*)(ws + OFF_REGB);
  f32x16 acc[2][2];
  gemm_tile<2, 2>(smem, sw, n0, sc, t0, 1024, acc, gr, pre, has_next, sw, tn2 * 128, sc, tm2 * 128);
  epi_store_f32_resid(smem, acc, Y + (size_t)t0 * 1024 + n0, xres + (size_t)t0 * 1024 + n0, 1024);
}
constexpr int LN_TASKS = T / 64;
DI void ln_task(const Params& p, int idx, int layer) {
  char* ws = p.ws;
  const int tid = threadIdx.x, lane = tid & 63, w = __builtin_amdgcn_readfirstlane(tid >> 6);
  const float* Y = (const float*)(ws + OFF_REGB);
  const float* lg = layer ? p.o_ln_g : p.e_ln_g; const float* lb = layer ? p.o_ln_b : p.e_ln_b;
  bf16_t* X1B = (bf16_t*)(ws + OFF_REGF);
  float4 gv[4], bv[4];
#pragma unroll
  for (int q = 0; q < 4; q++) { gv[q] = *(const float4*)(lg + q * 256 + lane * 4); bv[q] = *(const float4*)(lb + q * 256 + lane * 4); }
#pragma unroll 4
  for (int rr = 0; rr < 16; rr++) {
    size_t tok = (size_t)idx * 64 + w * 16 + rr;
    float4 v[4];
    float sum = 0.f;
#pragma unroll
    for (int q = 0; q < 4; q++) { v[q] = *(const float4*)(Y + tok * 1024 + q * 256 + lane * 4); sum += v[q].x + v[q].y + v[q].z + v[q].w; }
#pragma unroll
    for (int o = 32; o >= 1; o >>= 1) sum += __shfl_xor(sum, o);
    float mean = sum * (1.f / 1024.f);
    float sq = 0.f;
#pragma unroll
    for (int q = 0; q < 4; q++) sq += v[q].x * v[q].x + v[q].y * v[q].y + v[q].z * v[q].z + v[q].w * v[q].w;
#pragma unroll
    for (int o = 32; o >= 1; o >>= 1) sq += __shfl_xor(sq, o);
    sq = fmaxf(sq - 1024.f * mean * mean, 0.f);
#pragma unroll
    for (int q = 0; q < 4; q++) { v[q].x -= mean; v[q].y -= mean; v[q].z -= mean; v[q].w -= mean; }
    float rstd = rsqrtf(sq * (1.f / 1024.f) + EPS);
#pragma unroll
    for (int q = 0; q < 4; q++) {
      int n = q * 256 + lane * 4;
      float4 ov;
      ov.x = v[q].x * rstd * gv[q].x + bv[q].x; ov.y = v[q].y * rstd * gv[q].y + bv[q].y; ov.z = v[q].z * rstd * gv[q].z + bv[q].z; ov.w = v[q].w * rstd * gv[q].w + bv[q].w;
      *(float4*)(p.out + tok * 1024 + n) = ov;
      if (!layer) *(uint2*)(X1B + tok * 1024 + n) = pack4(ov.x, ov.y, ov.z, ov.w);
    }
  }
}

constexpr int P5_TOTAL = 256 * 14;
DI void p5_tile(const Params& p, char* smem, int tm, int tn, GemmRegs<2, 2>& gr, const bool pre, const bool has_next, int tm2, int tn2) {
  char* ws = p.ws;
  const int tid = threadIdx.x, lane = tid & 63, w = __builtin_amdgcn_readfirstlane(tid >> 6), wp = w >> 1, wq = w & 1, r = lane & 31, h = lane >> 5;
  SrcRM sx{(const bf16_t*)(ws + OFF_REGF), 1024}, sw{(const bf16_t*)(ws + OFF_WT_IN1), 1024};
  bf16_t* H1 = (bf16_t*)(ws + OFF_H1);
  f32x16 acc[2][2];
  const int t0 = tm * 128, n0 = tn * 128;
  gemm_tile<2, 2>(smem, sw, n0, sx, t0, 1024, acc, gr, pre, has_next, sw, tn2 * 128, sx, tm2 * 128);
  if (tn == 13 && wp == 0) {
    bf16_t* KR = (bf16_t*)(ws + OFF_KR);
#pragma unroll
    for (int iq = 0; iq < 2; iq++) {
      const size_t tok = (size_t)t0 + (wq * 2 + iq) * 32 + r;
      const float pos = (float)(int)(tok & 2047);
#pragma unroll
      for (int i = 0; i < 8; i++) {
        const int d = crow(i, h);
        float freq = expf(-9.210340371976184f * ((float)d * (1.f / 16.f)));
        float ang = pos * freq; float sn = __sinf(ang), cs = __cosf(ang);
        float x1 = __uint_as_float(f2bf(acc[0][iq][i]) << 16), x2 = __uint_as_float(f2bf(acc[0][iq][i + 8]) << 16);
        KR[tok * 32 + d] = (bf16_t)f2bf(x1 * cs - x2 * sn);
        KR[tok * 32 + 16 + d] = (bf16_t)f2bf(x2 * cs + x1 * sn);
      }
    }
  }
  epi_store_bf16_ssq(smem, acc, H1 + (size_t)t0 * H1LD + n0, H1LD, H1LD - n0, tn < 5 ? (float*)(ws + OFF_SSQ) + (size_t)tn * T + t0 : nullptr);
}

constexpr int P6_Q = 256 * 12, P6_TOTAL = P6_Q + 256 * 16;
DI void p6_task(const Params& p, char* smem, const bool isq, int tm, int tn, GemmRegs<2, 2>& gr, const bool pre, const bool has_next, int tm2, int tn2) {
  char* ws = p.ws;
  const int tid = threadIdx.x, lane = tid & 63, w = __builtin_amdgcn_readfirstlane(tid >> 6), wp = w >> 1, wq = w & 1, r = lane & 31, h = lane >> 5;
  const bf16_t* H1 = (const bf16_t*)(ws + OFF_H1);
  const int t0 = tm * 128, n0 = tn * 128;
  const int KD = isq ? 384 : 256, coff = isq ? 0 : 384;
  float* sRinv = (float*)(smem + 73728);
  if (tid < 128) {
    const float* sq = (const float*)(ws + OFF_SSQ) + (size_t)(t0 + tid);
    sRinv[tid] = isq ? rsqrtf((sq[0] + sq[T] + sq[2 * (size_t)T]) * (1.f / 384.f) + EPS) : rsqrtf((sq[3 * (size_t)T] + sq[4 * (size_t)T]) * (1.f / 256.f) + EPS);
  }
  __syncthreads();
  SrcRM sa{H1 + coff, H1LD};
  f32x16 acc[2][2];
  {
    SrcRM sw{(const bf16_t*)(ws + (isq ? OFF_WT_UQ : OFF_WT_UKV)), KD};
    const bool trv = !isq && tn >= 8;
    const bool trv2 = !isq && tn2 >= 8;
    const int t02 = tm2 * 128, n02 = tn2 * 128;
    gemm_tile<2, 2>(smem, trv ? sa : sw, trv ? t0 : n0, trv ? sw : sa, trv ? n0 : t0, KD, acc, gr, pre, has_next, trv2 ? sa : sw, trv2 ? t02 : n02, trv2 ? sw : sa, trv2 ? n02 : t02);
  }
  if (isq || tn < 8) {
    const float qs = isq ? 0.10206207261596575f : 1.f;
#pragma unroll
    for (int iq = 0; iq < 2; iq++) {
      float sc = sRinv[(wq * 2 + iq) * 32 + r] * qs;
#pragma unroll
      for (int ip = 0; ip < 2; ip++)
#pragma unroll
        for (int i = 0; i < 16; i++) acc[ip][iq][i] *= sc;
    }
    if (isq) epi_store_bf16(smem, acc, (bf16_t*)(ws + OFF_Q1) + (size_t)t0 * 1536 + n0, 1536, 128);
    else epi_store_bf16(smem, acc, (bf16_t*)(ws + OFF_K1) + (size_t)t0 * 1024 + n0, 1024, 128);
  } else {
#pragma unroll
    for (int ip = 0; ip < 2; ip++)
#pragma unroll
      for (int i = 0; i < 16; i++) {
        float sc = sRinv[(wp * 2 + ip) * 32 + crow(i, h)];
#pragma unroll
        for (int iq = 0; iq < 2; iq++) acc[ip][iq][i] *= sc;
      }
    const int b = t0 >> 11, s0 = t0 & 2047;
    epi_store_bf16(smem, acc, (bf16_t*)(ws + OFF_REGF) + ((size_t)(b * 1024 + (n0 - 1024))) * 2048 + s0, 2048, 128);
  }
}

constexpr int P7_TOTAL = 16 * 16 * 16;
DI void mla_task(const Params& p, char* smem, int idx) {
  char* ws = p.ws;
  const int qblk = 15 - (idx >> 8), hd = idx & 15, b = (idx >> 4) & 15;
  int tid_ = threadIdx.x; asm volatile("" : "+v"(tid_));
  const int tid = tid_, lane = tid & 63, w = __builtin_amdgcn_readfirstlane(tid >> 6), r = lane & 31, h = lane >> 5;
  const int t = qblk * 128 + w * 32 + r;
  const size_t tok = (size_t)b * 2048 + t;
  const bf16_t* Q1 = (const bf16_t*)(ws + OFF_Q1);
  const bf16_t* H1 = (const bf16_t*)(ws + OFF_H1);
  bf16x8 qf[6];
#pragma unroll
  for (int s = 0; s < 6; s++) qf[s] = *(const bf16x8*)(Q1 + tok * 1536 + hd * 96 + 16 * s + 8 * h);
  {
    union { bf16x8 v; unsigned short e[8]; } a, c;
    a.v = qf[4]; c.v = qf[5];
#pragma unroll
    for (int j = 0; j < 8; j++) {
      float freq = expf(-9.210340371976184f * ((float)(8 * h + j) * (1.f / 16.f)));
      float ang = (float)t * freq; float sn = __sinf(ang), cs = __cosf(ang);
      float x1 = bf2f(a.e[j]), x2 = bf2f(c.e[j]);
      a.e[j] = (unsigned short)f2bf(x1 * cs - x2 * sn);
      c.e[j] = (unsigned short)f2bf(x2 * cs + x1 * sn);
    }
    qf[4] = a.v; qf[5] = c.v;
  }
  f32x16 o[2];
#pragma unroll
  for (int dt = 0; dt < 2; dt++)
#pragma unroll
    for (int i = 0; i < 16; i++) o[dt][i] = 0.f;
  float m = -INFINITY, l = 0.f;
  const bf16_t* Kb = (const bf16_t*)(ws + OFF_K1) + (size_t)b * 2048 * 1024 + hd * 64;
  const bf16_t* KRb = (const bf16_t*)(ws + OFF_KR) + (size_t)b * 2048 * 32;
  const bf16_t* Vb = (const bf16_t*)(ws + OFF_REGF) + ((size_t)(b * 1024 + hd * 64)) * 2048;
  const int jhi = (qblk * 128 + 127) >> 6, wjhi = (qblk * 128 + w * 32 + 31) >> 6;
  const int tmin = qblk * 128 + w * 32;
  attn_loop<96, false>(tid, smem, qf, 0, jhi, 0xffffffffu, wjhi,
                [&](int key, int kc) { return kc < 8 ? Kb + (size_t)key * 1024 + kc * 8 : KRb + (size_t)key * 32 + (kc - 8) * 8; },
                [&](int row, int key) { return Vb + (size_t)row * 2048 + key; },
                LOG2E, 0.f, t,
                [&](int jt) { return jt * 64 + 63 > tmin; },
                [&](int key, int jt) { return key <= t; },
                o, m, l);
  l += __shfl_xor(l, 32);
  float inv = l > 0.f ? 1.f / l : 0.f;
  bf16_t* CAT = (bf16_t*)(ws + OFF_REGD);
#pragma unroll
  for (int dt = 0; dt < 2; dt++)
#pragma unroll
    for (int gg = 0; gg < 4; gg++) {
      int dv = 32 * dt + 8 * gg + 4 * h;
      uint2 z = *(const uint2*)(H1 + tok * H1LD + 640 + hd * 64 + dv);
      *(uint2*)(CAT + tok * 1024 + hd * 64 + dv) =
          pack4(o[dt][4 * gg] * inv * silu(bflo(z.x)), o[dt][4 * gg + 1] * inv * silu(bfhi(z.x)), o[dt][4 * gg + 2] * inv * silu(bflo(z.y)), o[dt][4 * gg + 3] * inv * silu(bfhi(z.y)));
    }
}


#define XB_TMO      128
#define XB_XCNT(j)  (256  + 64 * (j))
#define XB_XSUB(j)  (1280 + 64 * (j))
#define XB_XGEN(j)  (2304 + 64 * (j))
#define XB_TOP      3328
#define XB_TOPGEN   3392
#define XCD_BAR_WORDS 3456
#define XB_SPIN_CAP (1u << 18)
#define LAS __attribute__((address_space(3)))
DI unsigned xb_ld(unsigned* p) { return __hip_atomic_load(p, __ATOMIC_RELAXED, __HIP_MEMORY_SCOPE_AGENT); }
DI unsigned xb_add(unsigned* p, unsigned v) { return __hip_atomic_fetch_add(p, v, __ATOMIC_RELAXED, __HIP_MEMORY_SCOPE_AGENT); }
DI unsigned xb_xcc_id() { return (unsigned)__builtin_amdgcn_s_getreg((3 << 11) | 20) & 0xFu; }
#define XB_SPIN(cond, bar) do { unsigned _sp = 0; while (cond) { __builtin_amdgcn_s_sleep(1); \
    if ((++_sp & 255u) == 0u) { if (xb_ld(&(bar)[XB_TMO])) break; if (_sp > XB_SPIN_CAP) { atomicAdd(&(bar)[XB_TMO], 1u); break; } } } } while (0)
struct XcdBarrier { unsigned* bar; unsigned x; volatile LAS unsigned* st; };
DI XcdBarrier xcd_barrier_post(unsigned* bar, volatile LAS unsigned* st) {
  XcdBarrier b; b.bar = bar; b.x = xb_xcc_id(); b.st = st;
  if (threadIdx.x == 0) (void)xb_add(&bar[XB_XCNT(b.x)], 1u);
  return b;
}
DI void xcd_barrier_complete(unsigned* bar, unsigned x, unsigned& nloc, unsigned& nx) {
  const unsigned G = gridDim.x * gridDim.y * gridDim.z;
  unsigned sum, cnt, mine, sp = 0u;
  for (;;) {
    sum = 0u; cnt = 0u; mine = 0u;
#pragma unroll
    for (unsigned j = 0; j < 16; ++j) { const unsigned c = xb_ld(&bar[XB_XCNT(j)]); sum += c; cnt += (c > 0u) ? 1u : 0u; mine = (j == x) ? c : mine; }
    if (sum == G) break;
    __builtin_amdgcn_s_sleep(1);
    if ((++sp & 255u) == 0u) { if (xb_ld(&bar[XB_TMO])) break; if (sp > XB_SPIN_CAP) { atomicAdd(&bar[XB_TMO], 1u); break; } }
  }
  nloc = mine > 0u ? mine : 1u; nx = cnt > 0u ? cnt : 1u;
}
DI void xcd_barrier(const XcdBarrier& b) {
  asm volatile("s_waitcnt vmcnt(0)" ::: "memory");
  __syncthreads();
  if (threadIdx.x == 0) {
    unsigned* bar = b.bar;
    __builtin_amdgcn_s_waitcnt(0);
    unsigned nloc = b.st[0], nx = b.st[1];
    if (nloc == 0u) { xcd_barrier_complete(bar, b.x, nloc, nx); b.st[0] = nloc; b.st[1] = nx; }
    const unsigned old = xb_add(&bar[XB_XSUB(b.x)], 1u);
    const unsigned gen = old / nloc;
    if (old + 1u == (gen + 1u) * nloc) {
      __builtin_amdgcn_fence(__ATOMIC_RELEASE, "agent");
      asm volatile("s_waitcnt vmcnt(0)" ::: "memory");
      const unsigned og = xb_add(&bar[XB_TOP], 1u);
      const unsigned tg = og / nx;
      if (og + 1u == (tg + 1u) * nx) xb_add(&bar[XB_TOPGEN], 1u);
      else XB_SPIN(xb_ld(&bar[XB_TOPGEN]) == tg, bar);
      __builtin_amdgcn_fence(__ATOMIC_ACQUIRE, "agent");
      xb_add(&bar[XB_XGEN(b.x)], 1u);
      asm volatile("s_waitcnt vmcnt(0)" ::: "memory");
    } else {
      XB_SPIN(xb_ld(&bar[XB_XGEN(b.x)]) == gen, bar);
      __builtin_amdgcn_fence(__ATOMIC_ACQUIRE, "agent");
      asm volatile("s_waitcnt vmcnt(0)" ::: "memory");
    }
  }
  __syncthreads();
}

__global__ void __launch_bounds__(256, 2) nsa_gla_mla_mega(Params p) {
  __shared__ __attribute__((aligned(16))) char smem[SMEM_BYTES];
  __shared__ int s_task;
  __shared__ uint4 xb_words;
  cg::grid_group grid = cg::this_grid();
  if (threadIdx.x == 0) xb_words = make_uint4(0u, 0u, 0u, 0u);
  __syncthreads();
  XcdBarrier xb = xcd_barrier_post((unsigned*)(p.ws + OFF_CTR), (volatile LAS unsigned*)&xb_words);
  if (p.phase_end == 12345) grid.sync();
  int* ctr = (int*)(p.ws + OFF_CTR + 14336);
#ifndef SKIPMASK
#define SKIPMASK 0
#endif
#define PHASE_ON(n) (!((SKIPMASK >> (n)) & 1) && p.phase_begin <= (n) && (n) < p.phase_end)
#define PHASE_SYNC(n) if (p.phase_begin <= (n) && (n) + 1 < p.phase_end) xcd_barrier(xb);
#ifndef DUPMASK
#define DUPMASK 0
#endif
#define NREP(n) (1 + ((DUPMASK >> (n)) & 1))
#define XCD_TILE_LOOP(RT, CT, RS, CS, CALL) { const int x_ = blockIdx.x & 7, rs_ = x_ / (CS), cs_ = x_ % (CS); const int nr_ = (RT) / (RS), r0_ = rs_ * nr_; \
    const int c0_ = (cs_ * (CT)) / (CS), nc_ = ((cs_ + 1) * (CT)) / (CS) - c0_; \
    GemmRegs<2, 2> gr; bool pre = false; const int nt_ = nr_ * nc_, st_ = gridDim.x >> 3; \
    for (int j_ = blockIdx.x >> 3; j_ < nt_; j_ += st_) { const int tm = r0_ + j_ / nc_, tn = c0_ + j_ % nc_; const int j2_ = j_ + st_; const bool has_next = j2_ < nt_; \
      const int tm2 = r0_ + j2_ / nc_, tn2 = c0_ + j2_ % nc_; CALL; pre = has_next; } }
#define QUEUE_LOOP(CTR, NTASK, CALL) for (;;) { if (threadIdx.x == 0) s_task = atomicAdd(&ctr[CTR], 1); __syncthreads(); int tk = s_task; __syncthreads(); if (tk >= (NTASK)) break; CALL; __syncthreads(); }
  if (PHASE_ON(0)) for (int rep = 0; rep < NREP(0); rep++) for (int i = blockIdx.x; i < P0_TOTAL; i += gridDim.x) p0_task(p, smem, i);
  PHASE_SYNC(0)
  if (PHASE_ON(1)) for (int rep = 0; rep < NREP(1); rep++) XCD_TILE_LOOP(256, 27, 2, 4, p1_tile(p, smem, tm, tn, gr, pre, has_next, tm2, tn2))
  PHASE_SYNC(1)
  if (PHASE_ON(2)) for (int rep = 0; rep < NREP(2); rep++) {
    QUEUE_LOOP(3 + 8 * rep, P2_TOTAL, p2_task(p, smem, tk))
    QUEUE_LOOP(4 + 8 * rep, GLA_CHUNK_TASKS, gla_a_task(p, smem, tk))
  }
  PHASE_SYNC(2)
  if (PHASE_ON(3)) for (int rep = 0; rep < NREP(3); rep++) {
    QUEUE_LOOP(0 + 8 * rep, GLA_B_TASKS, gla_b_task(p, tk))
    QUEUE_LOOP(2 + 8 * rep, NSA_TASKS, nsa_task(p, smem, tk))
  }
  PHASE_SYNC(3)
  if (PHASE_ON(4)) for (int rep = 0; rep < NREP(4); rep++) for (int i = blockIdx.x; i < GLA_CHUNK_TASKS; i += gridDim.x) gla_c_task(p, smem, i);
  PHASE_SYNC(4)
  if (PHASE_ON(5)) for (int rep = 0; rep < NREP(5); rep++) XCD_TILE_LOOP(256, 8, 8, 1, outproj_tile(p, smem, tm, tn, 0, gr, pre, has_next, tm2, tn2))
  PHASE_SYNC(5)
  if (PHASE_ON(6)) for (int rep = 0; rep < NREP(6); rep++) for (int i = blockIdx.x; i < LN_TASKS; i += gridDim.x) ln_task(p, i, 0);
  PHASE_SYNC(6)
  if (PHASE_ON(7)) for (int rep = 0; rep < NREP(7); rep++) XCD_TILE_LOOP(256, 14, 4, 2, p5_tile(p, smem, tm, tn, gr, pre, has_next, tm2, tn2))
  PHASE_SYNC(7)
  if (PHASE_ON(9)) for (int rep = 0; rep < NREP(9); rep++) { XCD_TILE_LOOP(256, 16, 8, 1, p6_task(p, smem, false, tm, tn, gr, pre, has_next, tm2, tn2)) XCD_TILE_LOOP(256, 12, 8, 1, p6_task(p, smem, true, tm, tn, gr, pre, has_next, tm2, tn2)) }
  PHASE_SYNC(9)
  if (PHASE_ON(10)) for (int rep = 0; rep < NREP(10); rep++) {
    QUEUE_LOOP(1 + 8 * rep, P7_TOTAL, mla_task(p, smem, tk))
  }
  PHASE_SYNC(10)
  if (PHASE_ON(11)) XCD_TILE_LOOP(256, 8, 8, 1, outproj_tile(p, smem, tm, tn, 1, gr, pre, has_next, tm2, tn2))
  PHASE_SYNC(11)
  if (PHASE_ON(12)) for (int i = blockIdx.x; i < LN_TASKS; i += gridDim.x) ln_task(p, i, 1);
}

#ifndef N_LAUNCH_SPLIT
#define N_LAUNCH_SPLIT 0
#endif

extern "C" void kernel_launch(void* const* d_in, const int* in_sizes, int n_in, void* d_out, int out_size, void* d_ws, size_t ws_size,
                              hipStream_t stream) {
  static int grid_blocks = 0;
  if (!grid_blocks) {
    int dev = 0, cus = 0, per_cu = 0;
    hipGetDevice(&dev);
    hipDeviceGetAttribute(&cus, hipDeviceAttributeMultiprocessorCount, dev);
    hipOccupancyMaxActiveBlocksPerMultiprocessor(&per_cu, nsa_gla_mla_mega, 256, 0);
    if (per_cu < 1) per_cu = 1;
    if (per_cu > 2) per_cu = 2;
    grid_blocks = cus * per_cu;
  }
  Params p{};
  const float** f = (const float**)&p;
  for (int i = 0; i < 19; i++) f[i] = (const float*)d_in[i];
  p.out = (float*)d_out;
  p.ws = (char*)d_ws;
  (void)hipMemsetAsync((char*)d_ws + OFF_CTR, 0, 16384, stream);
#if N_LAUNCH_SPLIT
  for (int ph = 0; ph < 13; ph++) {
    p.phase_begin = ph; p.phase_end = ph + 1;
    hipLaunchKernelGGL(nsa_gla_mla_mega, dim3(grid_blocks), dim3(256), 0, stream, p);
  }
#else
  p.phase_begin = 0; p.phase_end = 13;
  void* args[] = {&p};
  hipError_t e = hipLaunchCooperativeKernel((void*)nsa_gla_mla_mega, dim3(grid_blocks), dim3(256), args, 0, stream);
  if (e != hipSuccess) fprintf(stderr, "cooperative launch failed: %s (grid %d)\n", hipGetErrorString(e), grid_blocks);
#endif
}
```
